# Optimizing an MI355X kernel written in HIP

```python
import jax, jax.numpy as jnp
from jax import lax
import numpy as np

D_MODEL = 1024
BATCH = 8
SEQ = 2048
DEPTH = 1
DEC_BATCH = 128
DEC_SEQ = 8
PAST_LEN = 16384
PAGE_SIZE = 128

POOL_WIDTH = D_MODEL // 2
CONV_WIDTH = D_MODEL - POOL_WIDTH
POOL_WINDOWS = (2, 4, 8, 16)
POOL_GROUPS = len(POOL_WINDOWS)
POOL_GROUP_DIM = POOL_WIDTH // POOL_GROUPS
POOL_HIST = max(POOL_WINDOWS) - 1
CONV_K = 3
FFN_K = 3
D_FF = ((8 * D_MODEL // 3 + 127) // 128) * 128
IN_WIDTH = POOL_WIDTH + 3 * CONV_WIDTH
EPS = 1e-6

kernel_name = "hybrid_pool_shortconv_convffn_step"


def rmsnorm(x, g):
    xf = x.astype(jnp.float32)
    y = xf * lax.rsqrt(jnp.mean(xf * xf, axis=-1, keepdims=True) + EPS)
    return (y * g.astype(jnp.float32)).astype(x.dtype)


def causal_dwconv(v_ext, w):
    k = w.shape[0]
    t = v_ext.shape[1] - (k - 1)
    out = w[0] * v_ext[:, 0:t]
    for j in range(1, k):
        out = out + w[j] * v_ext[:, j:j + t]
    return out


def pool_mix(u_ext, pos, w_grp, scale):
    n, l, c = u_ext.shape
    t = l - POOL_HIST
    uf = u_ext.astype(jnp.float32)
    cs = jnp.concatenate([jnp.zeros((n, 1, c), jnp.float32), jnp.cumsum(uf, axis=1)], axis=1)
    u_cur = uf[:, POOL_HIST:]
    posf = pos.astype(jnp.float32)
    diffs = []
    for g, win in enumerate(POOL_WINDOWS):
        sl = slice(g * POOL_GROUP_DIM, (g + 1) * POOL_GROUP_DIM)
        s = cs[:, POOL_HIST + 1:POOL_HIST + 1 + t, sl] - cs[:, POOL_HIST + 1 - win:POOL_HIST + 1 - win + t, sl]
        cnt = jnp.minimum(posf + 1.0, float(win))[None, :, None]
        diffs.append(s / cnt - u_cur[:, :, sl])
    d = jnp.stack(diffs, axis=2)
    y = jnp.einsum('ntgc,gcd->ntgd', d, w_grp.astype(jnp.float32)).reshape(n, t, c)
    return (y * scale.astype(jnp.float32)).astype(u_ext.dtype)


def layer(x, pos, st_pool, st_conv, st_ffn, g1, w_in, w_pool_grp, pool_scale, conv_w, w_out, g2, w_up, ffn_conv_w, w_down):
    h = rmsnorm(x, g1)
    z = jnp.einsum('ntd,de->nte', h, w_in)
    u = z[..., :POOL_WIDTH]
    gb = z[..., POOL_WIDTH:POOL_WIDTH + CONV_WIDTH]
    gc = z[..., POOL_WIDTH + CONV_WIDTH:POOL_WIDTH + 2 * CONV_WIDTH]
    hv = z[..., POOL_WIDTH + 2 * CONV_WIDTH:]
    u_ext = jnp.concatenate([st_pool.astype(u.dtype), u], axis=1)
    y_pool = pool_mix(u_ext, pos, w_pool_grp, pool_scale)
    new_pool = u_ext[:, -POOL_HIST:]
    vc_ext = jnp.concatenate([st_conv.astype(u.dtype), gc * hv], axis=1)
    y_conv = gb * causal_dwconv(vc_ext, conv_w)
    new_conv = vc_ext[:, -(CONV_K - 1):]
    x = x + jnp.einsum('nte,ed->ntd', jnp.concatenate([y_pool, y_conv], axis=-1), w_out)
    h2 = rmsnorm(x, g2)
    up = jnp.einsum('ntd,df->ntf', h2, w_up)
    up_ext = jnp.concatenate([st_ffn.astype(up.dtype), up], axis=1)
    upc = causal_dwconv(up_ext, ffn_conv_w)
    act = jax.nn.silu(upc[..., :D_FF]) * upc[..., D_FF:]
    x = x + jnp.einsum('ntf,fd->ntd', act, w_down)
    new_ffn = up_ext[:, -(FFN_K - 1):]
    return x, new_pool, new_conv, new_ffn


def setup_inputs(seed: int = 0) -> dict:
    key = jax.random.key(seed)
    ks = jax.random.split(key, 20)
    f32 = jnp.float32
    nrm = lambda k, s, sc: jax.random.normal(k, s, f32) * sc
    return {
        "x_prompt": nrm(ks[0], (BATCH, SEQ, D_MODEL), 1.0),
        "x_sample": nrm(ks[1], (DEC_BATCH, DEC_SEQ, D_MODEL), 1.0),
        "state_pool": nrm(ks[2], (DEPTH, DEC_BATCH, POOL_HIST, POOL_WIDTH), 1.0),
        "state_conv": nrm(ks[3], (DEPTH, DEC_BATCH, CONV_K - 1, CONV_WIDTH), 1.0),
        "state_ffn": nrm(ks[4], (DEPTH, DEC_BATCH, FFN_K - 1, 2 * D_FF), 1.0),
        "norm1_g": 1.0 + nrm(ks[5], (DEPTH, D_MODEL), 0.02),
        "w_in": nrm(ks[6], (DEPTH, D_MODEL, IN_WIDTH), D_MODEL ** -0.5),
        "w_pool_grp": nrm(ks[7], (DEPTH, POOL_GROUPS, POOL_GROUP_DIM, POOL_GROUP_DIM), POOL_GROUP_DIM ** -0.5),
        "pool_scale": 1.0 + nrm(ks[8], (DEPTH, POOL_WIDTH), 0.02),
        "conv_w": nrm(ks[9], (DEPTH, CONV_K, CONV_WIDTH), CONV_K ** -0.5),
        "w_out": nrm(ks[10], (DEPTH, D_MODEL, D_MODEL), D_MODEL ** -0.5),
        "norm2_g": 1.0 + nrm(ks[11], (DEPTH, D_MODEL), 0.02),
        "w_up": nrm(ks[12], (DEPTH, D_MODEL, 2 * D_FF), D_MODEL ** -0.5),
        "ffn_conv_w": nrm(ks[13], (DEPTH, FFN_K, 2 * D_FF), FFN_K ** -0.5),
        "w_down": nrm(ks[14], (DEPTH, D_FF, D_MODEL), D_FF ** -0.5),
        "final_g": 1.0 + nrm(ks[15], (D_MODEL,), 0.02),
    }


def reference(x_prompt, x_sample, state_pool, state_conv, state_ffn, norm1_g, w_in, w_pool_grp, pool_scale, conv_w, w_out, norm2_g, w_up, ffn_conv_w, w_down, final_g):
    bp = x_prompt.shape[0]
    pos_p = jnp.arange(x_prompt.shape[1], dtype=jnp.int32)
    pos_s = PAST_LEN + jnp.arange(x_sample.shape[1], dtype=jnp.int32)
    xp, xs = x_prompt, x_sample
    pp, cp, fp_, ps, cs_, fs = [], [], [], [], [], []
    for l in range(DEPTH):
        wl = (norm1_g[l], w_in[l], w_pool_grp[l], pool_scale[l], conv_w[l], w_out[l], norm2_g[l], w_up[l], ffn_conv_w[l], w_down[l])
        z_pool = jnp.zeros((bp, POOL_HIST, POOL_WIDTH), xp.dtype)
        z_conv = jnp.zeros((bp, CONV_K - 1, CONV_WIDTH), xp.dtype)
        z_ffn = jnp.zeros((bp, FFN_K - 1, 2 * D_FF), xp.dtype)
        xp, a, b, c = layer(xp, pos_p, z_pool, z_conv, z_ffn, *wl)
        pp.append(a); cp.append(b); fp_.append(c)
        xs, a, b, c = layer(xs, pos_s, state_pool[l], state_conv[l], state_ffn[l], *wl)
        ps.append(a); cs_.append(b); fs.append(c)
    y_prompt = rmsnorm(xp, final_g)
    y_sample = rmsnorm(xs, final_g)
    return (y_prompt, y_sample, jnp.stack(pp), jnp.stack(cp), jnp.stack(fp_), jnp.stack(ps), jnp.stack(cs_), jnp.stack(fs))
```

```cpp
#include <hip/hip_runtime.h>
#include <hip/hip_cooperative_groups.h>
#include <cstdio>
namespace cg = cooperative_groups;

#ifndef MULTI_LAUNCH
#define MULTI_LAUNCH 1
#endif

#define LAS __attribute__((address_space(3)))
typedef unsigned short bf16_t;
typedef short bf16x8 __attribute__((ext_vector_type(8)));
typedef float f32x4 __attribute__((ext_vector_type(4)));
typedef unsigned u32x4 __attribute__((ext_vector_type(4)));
typedef unsigned u32x2 __attribute__((ext_vector_type(2)));

constexpr int NTOK = 17408, NPR = 16384, DM = 1024, INW = 2048, FF = 2816, FF2 = 5632;
constexpr int SEQL = 2048;
constexpr float EPS = 1e-6f;

constexpr size_t MiB = 1u << 20;
constexpr size_t WS_WIN = 0, WS_WOUT = 4 * MiB, WS_WUP = 6 * MiB, WS_WDN = 17 * MiB, WS_SS = 23 * MiB, WS_EDGE = 24 * MiB, WS_FIRST = 27 * MiB,
                 WS_HB = 30 * MiB, WS_ZB = 64 * MiB, WS_A2 = 132 * MiB, WS_X1B = 166 * MiB, WS_ACT = 30 * MiB;
constexpr size_t O_Y = 0, O_NPP = 17825792, O_NCP = 17887232, O_NFP = 17895424, O_NPS = 17985536, O_NCS = 18968576, O_NFS = 19099648;

struct Params {
    const float *x_prompt, *x_sample, *st_pool, *st_conv, *st_ffn, *g1, *w_in, *w_grp, *pool_scale, *conv_w, *w_out, *g2, *w_up, *ffn_cw, *w_down, *gf;
    float* out; unsigned char* ws;
};

constexpr int BM = 256, BK = 64, HALF = 128, HTB = HALF * BK * 2, STAGE_BYTES = 8 * HTB, NXCD = 8, WGM = 8;
constexpr int XCH_BYTES = 8192, LDS_BYTES = STAGE_BYTES + XCH_BYTES;

__device__ __forceinline__ int lds_byte(int r, int c) { const int st = (r >> 4) * 2 + (c >> 5), rr = r & 15, cc = c & 31, ob = rr * 64 + cc * 2; return st * 1024 + (ob ^ (((ob >> 9) & 1) << 5)); }
__device__ __forceinline__ void stage_rc(int b, int& R, int& C) { const int st = b / 1024, sb = b % 1024, swz = sb ^ (((sb >> 9) & 1) << 5); R = (st >> 1) * 16 + swz / 64; C = (st & 1) * 32 + (swz % 64) / 2; }
__device__ __forceinline__ int perm32(int rho) { const int n = rho >> 4, i = rho & 15; return 8 * (i >> 2) + 4 * n + (i & 3); }

struct Unit { int pm, pn; };
struct Gemm { const bf16_t* A; const bf16_t* Bt; int M, N, K; };

struct StaticOrder {
    int nM, nN, nwg, G, c;
    __device__ void init(int M, int N, int G_, int c_) { nM = M / BM; nN = N / BM; nwg = nM * nN; G = G_; c = c_; }
    __device__ bool next(int i, Unit& u) const {
        const long L = (long)i * G + c; if (L >= nwg) return false;
        int wgid = (int)L; { const int q = nwg / NXCD, r = nwg % NXCD, xcd = wgid % NXCD, off = wgid / NXCD; wgid = (xcd < r ? xcd * (q + 1) : r * (q + 1) + (xcd - r) * q) + off; }
        const int nig = WGM * nN, gid = wgid / nig, fm = gid * WGM, gsz = (nM - fm) < WGM ? (nM - fm) : WGM;
        u.pm = fm + ((wgid % nig) % gsz); u.pn = (wgid % nig) / gsz; return true;
    }
};

__device__ __forceinline__ unsigned cvt_pk_bf16(float lo, float hi) { unsigned r; asm("v_cvt_pk_bf16_f32 %0, %1, %2" : "=v"(r) : "v"(lo), "v"(hi)); return r; }
__device__ __forceinline__ float bf_lo(unsigned w) { return __uint_as_float(w << 16); }
__device__ __forceinline__ float bf_hi(unsigned w) { return __uint_as_float(w & 0xffff0000u); }
__device__ __forceinline__ void unpack8(const u32x4 w, float (&f)[8]) { f[0] = bf_lo(w.x); f[1] = bf_hi(w.x); f[2] = bf_lo(w.y); f[3] = bf_hi(w.y); f[4] = bf_lo(w.z); f[5] = bf_hi(w.z); f[6] = bf_lo(w.w); f[7] = bf_hi(w.w); }
__device__ __forceinline__ u32x4 pack8(const float (&f)[8]) { u32x4 w; w.x = cvt_pk_bf16(f[0], f[1]); w.y = cvt_pk_bf16(f[2], f[3]); w.z = cvt_pk_bf16(f[4], f[5]); w.w = cvt_pk_bf16(f[6], f[7]); return w; }
__device__ __forceinline__ float wave_sum(float v) {
#pragma unroll
    for (int o = 1; o < 64; o <<= 1) v += __shfl_xor(v, o);
    return v;
}
template <int CTRL> __device__ __forceinline__ float dppf(float v) { return __int_as_float(__builtin_amdgcn_update_dpp(0, __float_as_int(v), CTRL, 0xf, 0xf, true)); }

struct EpiZ {
    bf16_t* O; int ldc;
    __device__ __forceinline__ void operator()(const f32x4 (&acc)[2][2][4][2], const Unit& u, int wr, int wc, int fr, int fq, LAS unsigned char*) const {
        const int row0 = u.pm * BM + wr * 64 + fr, col0 = u.pn * BM + wc * 32 + 8 * fq;
#pragma unroll
        for (int ai = 0; ai < 2; ++ai)
#pragma unroll
            for (int m = 0; m < 4; ++m) { bf16_t* rowp = O + (size_t)(row0 + ai * HALF + m * 16) * ldc + col0;
#pragma unroll
                for (int bj = 0; bj < 2; ++bj) { const f32x4 v0 = acc[ai][bj][m][0], v1 = acc[ai][bj][m][1];
                    u32x4 w; w.x = cvt_pk_bf16(v0[0], v0[1]); w.y = cvt_pk_bf16(v0[2], v0[3]); w.z = cvt_pk_bf16(v1[0], v1[1]); w.w = cvt_pk_bf16(v1[2], v1[3]);
                    *(u32x4*)(rowp + bj * HALF) = w; } }
    }
};
struct EpiRes {
    const float* rp; const float* rs; float* xout; bf16_t* xb; float* ss;
    __device__ __forceinline__ void operator()(const f32x4 (&acc)[2][2][4][2], const Unit& u, int wr, int wc, int fr, int fq, LAS unsigned char*) const {
        const int row0 = u.pm * BM + wr * 64 + fr, col0 = u.pn * BM + wc * 32 + 8 * fq;
        const float* src0 = (u.pm < 64) ? rp + (size_t)row0 * DM : rs + (size_t)(row0 - NPR) * DM;
#pragma unroll
        for (int ai = 0; ai < 2; ++ai)
#pragma unroll
            for (int m = 0; m < 4; ++m) {
                const int row = row0 + ai * HALF + m * 16;
                const float* src = src0 + (size_t)(ai * HALF + m * 16) * DM + col0;
                float* dst = xout + (size_t)row * DM + col0;
                float q = 0.f;
#pragma unroll
                for (int bj = 0; bj < 2; ++bj) {
                    const f32x4 r0 = *(const f32x4*)(src + bj * HALF), r1 = *(const f32x4*)(src + bj * HALF + 4);
                    const f32x4 v0 = acc[ai][bj][m][0] + r0, v1 = acc[ai][bj][m][1] + r1;
                    *(f32x4*)(dst + bj * HALF) = v0; *(f32x4*)(dst + bj * HALF + 4) = v1;
                    if (xb) { u32x4 w; w.x = cvt_pk_bf16(v0[0], v0[1]); w.y = cvt_pk_bf16(v0[2], v0[3]); w.z = cvt_pk_bf16(v1[0], v1[1]); w.w = cvt_pk_bf16(v1[2], v1[3]);
                        *(u32x4*)(xb + (size_t)row * DM + col0 + bj * HALF) = w; }
                    q += (v0[0] * v0[0] + v0[1] * v0[1]) + (v0[2] * v0[2] + v0[3] * v0[3]) + (v1[0] * v1[0] + v1[1] * v1[1]) + (v1[2] * v1[2] + v1[3] * v1[3]);
                }
                q += __shfl_xor(q, 16); q += __shfl_xor(q, 32);
                if (fq == 0) atomicAdd(ss + row, q);
            }
    }
};

struct EpiUp {
    const float* ss2; const float* cw; const float* st_ffn; bf16_t* actb; float* edge; float* first; float* nfp; float* nfs;

    template <bool SAMPLE>
    __device__ __forceinline__ void body(const f32x4 (&acc)[2][2][4][2], const Unit& u, int wr, int wc, int fr, int fq, LAS unsigned char* lds) const {
        const int wid = wr * 4 + wc;
        const int f0 = u.pn * 128 + wc * 32 + 8 * fq;
        const int rowb = u.pm * BM + wr * 64 + fr;
        float rstd[2][4];
#pragma unroll
        for (int ai = 0; ai < 2; ++ai)
#pragma unroll
            for (int m = 0; m < 4; ++m) rstd[ai][m] = rsqrtf(ss2[rowb + ai * HALF + m * 16] * (1.0f / DM) + EPS);

        LAS float* xch = (LAS float*)(lds + STAGE_BYTES);
        if (!SAMPLE) {
            if (fr >= 14) {
#pragma unroll
                for (int ai = 0; ai < 2; ++ai) {
                    LAS float* dst = xch + ((((wid * 2 + ai) * 4 + fq) * 2 + (fr - 14)) * 16);
                    const float r = rstd[ai][3];
#pragma unroll
                    for (int bj = 0; bj < 2; ++bj)
#pragma unroll
                        for (int n = 0; n < 2; ++n) *(LAS f32x4*)(dst + bj * 8 + n * 4) = acc[ai][bj][3][n] * r;
                }
            }
            asm volatile("s_waitcnt lgkmcnt(0)" ::: "memory"); __builtin_amdgcn_s_barrier(); asm volatile("" ::: "memory"); __builtin_amdgcn_s_barrier(); asm volatile("" ::: "memory");
        }
        const int s8 = fr & 7;
        const float mk1 = SAMPLE ? 0.f : (fr == 0 ? 1.f : 0.f), mk0 = SAMPLE ? 0.f : (fr < 2 ? 1.f : 0.f);
#pragma unroll
        for (int n = 0; n < 2; ++n) {
            const int fn = f0 + 4 * n;
            f32x4 wa[3], wb[3];
#pragma unroll
            for (int j = 0; j < 3; ++j) { wa[j] = *(const f32x4*)(cw + j * FF2 + fn); wb[j] = *(const f32x4*)(cw + j * FF2 + FF + fn); }
            f32x4 pa, pb;
#pragma unroll
            for (int ai = 0; ai < 2; ++ai) {
                if (!SAMPLE) {
                    if (ai == 0 && wr == 0) { pa = (f32x4){0.f, 0.f, 0.f, 0.f}; pb = pa; }
                    else {
                        const int swid = ((wr ^ 1) << 2) | wc, sai = (ai == 1 && wr == 1) ? 1 : 0;
                        const LAS float* src = xch + ((((swid * 2 + sai) * 4 + fq) * 2 + (fr & 1)) * 16);
                        pa = *(const LAS f32x4*)(src + 4 * n); pb = *(const LAS f32x4*)(src + 8 + 4 * n);
                    }
                }
#pragma unroll
                for (int m = 0; m < 4; ++m) {
                    const int row = rowb + ai * HALF + m * 16;
                    const float r = rstd[ai][m];
                    const f32x4 va = acc[ai][0][m][n] * r, vb = acc[ai][1][m][n] * r;
                    f32x4 b1a, b2a, b1b, b2b;
                    const f32x4 z4 = (f32x4){0.f, 0.f, 0.f, 0.f};
                    if (SAMPLE) {
                        const int bseq = (row - NPR) >> 3;
                        const float* h0 = st_ffn + (size_t)bseq * 2 * FF2 + fn; const float* h1 = h0 + FF2;
                        b1a = z4; b2a = z4; b1b = z4; b2b = z4;
                        if (s8 < 2) {
                            const f32x4 h1a = *(const f32x4*)(h1), h1b = *(const f32x4*)(h1 + FF);
                            if (s8 == 0) { b1a = h1a; b1b = h1b; b2a = *(const f32x4*)(h0); b2b = *(const f32x4*)(h0 + FF); }
                            else { b2a = h1a; b2b = h1b; }
                        }
                    } else {
#pragma unroll
                        for (int e = 0; e < 4; ++e) { b1a[e] = mk1 * dppf<0x121>(pa[e]); b2a[e] = mk0 * dppf<0x122>(pa[e]); b1b[e] = mk1 * dppf<0x121>(pb[e]); b2b[e] = mk0 * dppf<0x122>(pb[e]); }
                    }
                    float act[4];
#pragma unroll
                    for (int e = 0; e < 4; ++e) {
                        float xa1 = va[e], xa2 = va[e], xb1 = vb[e], xb2 = vb[e];
                        if (SAMPLE) { if (s8 == 7) { xa1 = 0.f; xb1 = 0.f; } if (s8 >= 6) { xa2 = 0.f; xb2 = 0.f; } }
                        float ca = wa[2][e] * va[e]; ca = fmaf(wa[1][e], dppf<0x111>(xa1), ca); ca = fmaf(wa[0][e], dppf<0x112>(xa2), ca); ca = fmaf(wa[1][e], b1a[e], ca); ca = fmaf(wa[0][e], b2a[e], ca);
                        float cb = wb[2][e] * vb[e]; cb = fmaf(wb[1][e], dppf<0x111>(xb1), cb); cb = fmaf(wb[0][e], dppf<0x112>(xb2), cb); cb = fmaf(wb[1][e], b1b[e], cb); cb = fmaf(wb[0][e], b2b[e], cb);
                        const float sg = __builtin_amdgcn_rcpf(1.0f + __builtin_amdgcn_exp2f(ca * -1.44269504f));
                        act[e] = ca * sg * cb;
                    }
                    { u32x2 w; w.x = cvt_pk_bf16(act[0], act[1]); w.y = cvt_pk_bf16(act[2], act[3]); *(u32x2*)(actb + (size_t)row * FF + fn) = w; }
                    if (SAMPLE) {
                        if (s8 >= 6) { float* d = nfs + ((size_t)((row - NPR) >> 3) * 2 + (s8 - 6)) * FF2 + fn; *(f32x4*)(d) = va; *(f32x4*)(d + FF) = vb; }
                    } else {
                        if (ai == 1 && wr == 1 && m == 3 && fr >= 14) {
                            float* d = edge + ((size_t)u.pm * 2 + (fr - 14)) * FF2 + fn; *(f32x4*)(d) = va; *(f32x4*)(d + FF) = vb;
                            if ((u.pm & 7) == 7) { float* d2 = nfp + ((size_t)(u.pm >> 3) * 2 + (fr - 14)) * FF2 + fn; *(f32x4*)(d2) = va; *(f32x4*)(d2 + FF) = vb; }
                        }
                        if (ai == 0 && wr == 0 && m == 0 && fr < 2) { float* d = first + ((size_t)u.pm * 2 + fr) * FF2 + fn; *(f32x4*)(d) = va; *(f32x4*)(d + FF) = vb; }
                        pa = va; pb = vb;
                    }
                    __builtin_amdgcn_sched_barrier(0);
                }
            }
        }
    }
    __device__ __forceinline__ void operator()(const f32x4 (&acc)[2][2][4][2], const Unit& u, int wr, int wc, int fr, int fq, LAS unsigned char* lds) const {
        if (u.pm >= 64) body<true>(acc, u, wr, wc, fr, fq, lds); else body<false>(acc, u, wr, wc, fr, fq, lds);
    }
};

template <class Epi>
__device__ __forceinline__ void gemm_phase(LAS unsigned char* lds, const Gemm g, const StaticOrder& S, const Epi& E) {
    const int tid = threadIdx.x, wid = __builtin_amdgcn_readfirstlane(tid >> 6), lane = tid & 63, wr = wid >> 2, wc = wid & 3, fr = lane & 15, fq = lane >> 4;
    const int K = g.K, nt = K / BK;
    unsigned voffA[2], voffB[2];
#pragma unroll
    for (int i = 0; i < 2; ++i) { int R, C; stage_rc(tid * 16 + i * 8192, R, C); const int Rb = (R & ~31) + perm32(R & 31);
        voffA[i] = (unsigned)(R * K + C) * 2u; voffB[i] = (unsigned)(Rb * K + C) * 2u; }
    const size_t kstep = (size_t)(BK * 2);
    const size_t hstep = (size_t)HALF * K * 2;
    const size_t tstep = 2 * hstep;
    const unsigned ldsw = (unsigned)wid * 1024u;
    const int aoff = lds_byte(wr * 64 + fr, fq * 8), boff = lds_byte(wc * 32 + fr, fq * 8);
#define PG8_SA(b, h) (((b) * 2 + (h)) * HTB)
#define PG8_SB(b, h) ((4 + (b) * 2 + (h)) * HTB)
#define PG8_STAGE(bufoff, gbase, voff) do { _Pragma("unroll") for (int _i = 0; _i < 2; ++_i) \
        __builtin_amdgcn_global_load_lds((const unsigned*)((const char*)(gbase) + (voff)[_i]), (LAS unsigned*)(lds + (bufoff) + ldsw + _i * 8192), 16, 0, 0); } while (0)
#define PG8_LDA(dst, b, h) do { _Pragma("unroll") for (int m = 0; m < 4; ++m) _Pragma("unroll") for (int k = 0; k < 2; ++k) dst[m][k] = *(const LAS bf16x8*)(lds + PG8_SA(b, h) + aoff + m * 2048 + k * 1024); } while (0)
#define PG8_LDB(dst, b, h) do { _Pragma("unroll") for (int n = 0; n < 2; ++n) _Pragma("unroll") for (int k = 0; k < 2; ++k) dst[n][k] = *(const LAS bf16x8*)(lds + PG8_SB(b, h) + boff + n * 2048 + k * 1024); } while (0)
#define PG8_MMA(ai, bj, At, Bt) do { __builtin_amdgcn_s_setprio(1); _Pragma("unroll") for (int m = 0; m < 4; ++m) _Pragma("unroll") for (int n = 0; n < 2; ++n) _Pragma("unroll") for (int k = 0; k < 2; ++k) \
        acc[ai][bj][m][n] = __builtin_amdgcn_mfma_f32_16x16x32_bf16(Bt[n][k], At[m][k], acc[ai][bj][m][n], 0, 0, 0); __builtin_amdgcn_s_setprio(0); } while (0)
#define PG8_WAIT_V(n) asm volatile("s_waitcnt vmcnt(" #n ")" ::: "memory")
#define PG8_WAIT_L(n) asm volatile("s_waitcnt lgkmcnt(" #n ")" ::: "memory")
#define PG8_BAR __builtin_amdgcn_s_barrier()
#define PG8_SCHED __builtin_amdgcn_sched_barrier(0)
    Unit cur, nxt; int ui = 0;
    if (!S.next(0, cur)) return;
    f32x4 acc[2][2][4][2];
#pragma unroll
    for (int a = 0; a < 2; ++a)
#pragma unroll
        for (int b = 0; b < 2; ++b)
#pragma unroll
            for (int m = 0; m < 4; ++m)
#pragma unroll
                for (int n = 0; n < 2; ++n) acc[a][b][m][n] = (f32x4){0.f, 0.f, 0.f, 0.f};
    bf16x8 At[4][2], B0[2][2], B1[2][2];
    const char* cA = (const char*)g.A + (size_t)cur.pm * tstep; const char* cB = (const char*)g.Bt + (size_t)cur.pn * tstep;
    PG8_STAGE(PG8_SB(0, 0), cB, voffB); PG8_STAGE(PG8_SA(0, 0), cA, voffA); PG8_STAGE(PG8_SB(0, 1), cB + hstep, voffB); PG8_STAGE(PG8_SA(0, 1), cA + hstep, voffA);
    if (wr == 1) PG8_BAR;
    PG8_WAIT_V(4); PG8_BAR;
    PG8_STAGE(PG8_SB(1, 0), cB + kstep, voffB); PG8_STAGE(PG8_SA(1, 0), cA + kstep, voffA); PG8_STAGE(PG8_SB(1, 1), cB + hstep + kstep, voffB);
    PG8_WAIT_V(6); PG8_BAR;
    for (;;) {
        const bool has_next = S.next(ui + 1, nxt);
        const char* nA = has_next ? (const char*)g.A + (size_t)nxt.pm * tstep : cA; const char* nB = has_next ? (const char*)g.Bt + (size_t)nxt.pn * tstep : cB;
        for (int t = 0; t < nt; t += 2) {
            const bool last = (t == nt - 2);
            const char* a1 = cA + (size_t)(t + 1) * kstep;
            const char* a2 = last ? nA : cA + (size_t)(t + 2) * kstep; const char* b2 = last ? nB : cB + (size_t)(t + 2) * kstep;
            const char* a3 = a2 + kstep; const char* b3 = b2 + kstep;
            PG8_LDB(B0, 0, 0); PG8_SCHED; PG8_LDA(At, 0, 0); PG8_STAGE(PG8_SA(1, 1), a1 + hstep, voffA);
            PG8_WAIT_L(8); PG8_BAR; PG8_WAIT_L(0); PG8_MMA(0, 0, At, B0); PG8_BAR; PG8_SCHED;
            PG8_LDB(B1, 0, 1); PG8_STAGE(PG8_SB(0, 0), b2, voffB);
            PG8_BAR; PG8_WAIT_L(0); PG8_MMA(0, 1, At, B1); PG8_BAR;
            PG8_LDA(At, 0, 1); PG8_STAGE(PG8_SA(0, 0), a2, voffA);
            PG8_BAR; PG8_WAIT_L(0); PG8_MMA(1, 0, At, B0); PG8_BAR; PG8_SCHED;
            PG8_STAGE(PG8_SB(0, 1), b2 + hstep, voffB);
            PG8_WAIT_V(6); PG8_BAR; PG8_MMA(1, 1, At, B1); PG8_BAR;
            PG8_LDB(B0, 1, 0); PG8_SCHED; PG8_LDA(At, 1, 0); PG8_STAGE(PG8_SA(0, 1), a2 + hstep, voffA);
            PG8_WAIT_L(8); PG8_BAR; PG8_WAIT_L(0); PG8_MMA(0, 0, At, B0); PG8_BAR; PG8_SCHED;
            PG8_LDB(B1, 1, 1); PG8_STAGE(PG8_SB(1, 0), b3, voffB);
            PG8_BAR; PG8_WAIT_L(0); PG8_MMA(0, 1, At, B1); PG8_BAR;
            PG8_LDA(At, 1, 1); PG8_STAGE(PG8_SA(1, 0), a3, voffA);
            PG8_BAR; PG8_WAIT_L(0); PG8_MMA(1, 0, At, B0); PG8_BAR; PG8_SCHED;
            PG8_STAGE(PG8_SB(1, 1), b3 + hstep, voffB);
            PG8_WAIT_V(6); PG8_BAR; PG8_MMA(1, 1, At, B1); PG8_BAR;
        }
        E(acc, cur, wr, wc, fr, fq, lds);
        if (!has_next) break;
#pragma unroll
        for (int a = 0; a < 2; ++a)
#pragma unroll
            for (int b = 0; b < 2; ++b)
#pragma unroll
                for (int m = 0; m < 4; ++m)
#pragma unroll
                    for (int n = 0; n < 2; ++n) acc[a][b][m][n] = (f32x4){0.f, 0.f, 0.f, 0.f};
        cur = nxt; cA = nA; cB = nB; ++ui;
    }
    PG8_WAIT_V(0);
    if (wr == 0) PG8_BAR;
    PG8_BAR;
#undef PG8_SA
#undef PG8_SB
#undef PG8_STAGE
#undef PG8_LDA
#undef PG8_LDB
#undef PG8_MMA
#undef PG8_WAIT_V
#undef PG8_WAIT_L
#undef PG8_BAR
#undef PG8_SCHED
}

#define LDS_WAIT() asm volatile("s_waitcnt lgkmcnt(0)" ::: "memory")
template <int MODE>
__device__ __forceinline__ void p0_transpose_item(const float* W, int K, int N, const float* gain, bf16_t* WT, LAS float* scr, int item, int lane) {
    const int nblk = N / 32, kb = item / nblk, nb = item % nblk, k0 = 64 * kb, n0 = 32 * nb;
#pragma unroll 8
    for (int i = 0; i < 32; ++i) { const int kk = 2 * i + (lane >> 5); float v = W[(size_t)(k0 + kk) * N + n0 + (lane & 31)]; if (gain) v *= gain[k0 + kk]; scr[kk * 33 + (lane & 31)] = v; }
    LDS_WAIT(); asm volatile("" ::: "memory");
    const int c = lane & 7;
#pragma unroll
    for (int j = 0; j < 4; ++j) { const int n = (lane >> 3) + 8 * j; const LAS float* s = scr + (8 * c) * 33 + n;
        u32x4 o; o.x = cvt_pk_bf16(s[0 * 33], s[1 * 33]); o.y = cvt_pk_bf16(s[2 * 33], s[3 * 33]); o.z = cvt_pk_bf16(s[4 * 33], s[5 * 33]); o.w = cvt_pk_bf16(s[6 * 33], s[7 * 33]);
        int row = n0 + n;
        if (MODE == 2) { const int half = row >= FF ? 1 : 0, f = row - half * FF; row = (f >> 7) * 256 + half * 128 + (f & 127); }
        *(u32x4*)(WT + (size_t)row * K + k0 + 8 * c) = o; }
    LDS_WAIT(); asm volatile("" ::: "memory");
}

__device__ __forceinline__ void phase0(const Params& p, LAS unsigned char* lds) {
    const int tid = threadIdx.x, lane = tid & 63, wave = __builtin_amdgcn_readfirstlane(tid >> 6);
    const int G = gridDim.x;
    float* ss = (float*)(p.ws + WS_SS);
    for (int i = blockIdx.x * 512 + tid; i < 2 * NTOK; i += G * 512) ss[i] = 0.f;
    bf16_t* Wt_in = (bf16_t*)(p.ws + WS_WIN); bf16_t* Wt_out = (bf16_t*)(p.ws + WS_WOUT); bf16_t* Wt_up = (bf16_t*)(p.ws + WS_WUP); bf16_t* Wt_dn = (bf16_t*)(p.ws + WS_WDN);
    bf16_t* hb = (bf16_t*)(p.ws + WS_HB);
    LAS float* scr = (LAS float*)(lds + wave * 16384);
    const int gw = blockIdx.x * 8 + wave, NGW = G * 8;
    constexpr int I_FOLD = 1024, I_IN = 16 * 64, I_OUT = 8 * 32, I_UP = 16 * 176, I_DN = 44 * 32, I_ROWS = NTOK;
    constexpr int NITEMS = I_FOLD + I_IN + I_OUT + I_UP + I_DN + I_ROWS;
    for (int it = gw; it < NITEMS; it += NGW) {
        int r = it;
        if (r < I_FOLD) {
            const int cblk = r >> 4, n = (r & 15) * 64 + lane, g = cblk >> 4, c0 = (cblk & 15) * 8;
            float a8[8];
#pragma unroll
            for (int e = 0; e < 8; ++e) a8[e] = 0.f;
            const float* wg = p.w_grp + (size_t)(g * 128 + c0) * 128;
#pragma unroll 4
            for (int d = 0; d < 128; ++d) {
                const float a = p.w_out[(size_t)(g * 128 + d) * DM + n] * p.pool_scale[g * 128 + d];
#pragma unroll
                for (int e = 0; e < 8; ++e) a8[e] = fmaf(wg[e * 128 + d], a, a8[e]);
            }
            *(u32x4*)(Wt_out + (size_t)n * DM + g * 128 + c0) = pack8(a8);
            continue;
        }
        r -= I_FOLD;
        if (r < I_IN) { p0_transpose_item<0>(p.w_in, DM, INW, p.g1, Wt_in, scr, r, lane); continue; } r -= I_IN;
        if (r < I_OUT) { p0_transpose_item<0>(p.w_out + (size_t)512 * DM, DM, DM, nullptr, Wt_out + 512, scr, r, lane); continue; } r -= I_OUT;
        if (r < I_UP) { p0_transpose_item<2>(p.w_up, DM, FF2, p.g2, Wt_up, scr, r, lane); continue; } r -= I_UP;
        if (r < I_DN) { p0_transpose_item<0>(p.w_down, FF, DM, nullptr, Wt_dn, scr, r, lane); continue; } r -= I_DN;
        {
            const float* xr = r < NPR ? p.x_prompt + (size_t)r * DM : p.x_sample + (size_t)(r - NPR) * DM;
            f32x4 v[4]; float s = 0.f;
#pragma unroll
            for (int j = 0; j < 4; ++j) { v[j] = ((const f32x4*)xr)[lane + 64 * j]; s += (v[j][0] * v[j][0] + v[j][1] * v[j][1]) + (v[j][2] * v[j][2] + v[j][3] * v[j][3]); }
            const float rstd = rsqrtf(wave_sum(s) * (1.0f / DM) + EPS);
            u32x2* o = (u32x2*)(hb + (size_t)r * DM) + lane;
#pragma unroll
            for (int j = 0; j < 4; ++j) { u32x2 w; w.x = cvt_pk_bf16(v[j][0] * rstd, v[j][1] * rstd); w.y = cvt_pk_bf16(v[j][2] * rstd, v[j][3] * rstd); o[64 * j] = w; }
        }
    }
}

__device__ __forceinline__ void ld8(const bf16_t* p, float (&f)[8]) { unpack8(*(const u32x4*)p, f); }
__device__ __forceinline__ void ld8f(const float* p, float (&f)[8]) { const f32x4 a = *(const f32x4*)p, b = *(const f32x4*)(p + 4); f[0] = a[0]; f[1] = a[1]; f[2] = a[2]; f[3] = a[3]; f[4] = b[0]; f[5] = b[1]; f[6] = b[2]; f[7] = b[3]; }
__device__ __forceinline__ void st8f(float* p, const float (&f)[8]) { *(f32x4*)p = (f32x4){f[0], f[1], f[2], f[3]}; *(f32x4*)(p + 4) = (f32x4){f[4], f[5], f[6], f[7]}; }

__device__ __forceinline__ void phase2(const Params& p) {
    const bf16_t* zb = (const bf16_t*)(p.ws + WS_ZB); bf16_t* A2 = (bf16_t*)(p.ws + WS_A2);
    const int total = NTOK * 128;
    for (int it = blockIdx.x * 512 + threadIdx.x; it < total; it += gridDim.x * 512) {
        const int r = it >> 7, v = it & 127;
        const bool samp = r >= NPR;
        const int rr = r - NPR, bq = samp ? (rr >> 3) : (r >> 11), t = samp ? (rr & 7) : (r & 2047);
        if (v < 64) {
            const int c = v * 8, g = v >> 4, win = 2 << g;
            float cur[8], sum[8], tmp[8];
            ld8(zb + (size_t)r * INW + c, cur);
#pragma unroll
            for (int e = 0; e < 8; ++e) sum[e] = cur[e];
            for (int k = 1; k < win; ++k) {
                const int idx = t - k;
                if (idx >= 0) ld8(zb + (size_t)(r - k) * INW + c, tmp);
                else if (samp) ld8f(p.st_pool + ((size_t)bq * 15 + 15 + idx) * 512 + c, tmp);
                else break;
#pragma unroll
                for (int e = 0; e < 8; ++e) sum[e] += tmp[e];
            }
            const float cnt = samp ? (float)win : (float)min(t + 1, win);
            const float inv = 1.0f / cnt;
            float d[8];
#pragma unroll
            for (int e = 0; e < 8; ++e) d[e] = sum[e] * inv - cur[e];
            *(u32x4*)(A2 + (size_t)r * DM + c) = pack8(d);
            if (!samp) { if (t >= SEQL - 15) st8f(p.out + O_NPP + ((size_t)bq * 15 + (t - (SEQL - 15))) * 512 + c, cur); }
            else {
                st8f(p.out + O_NPS + ((size_t)bq * 15 + 7 + t) * 512 + c, cur);
                if (t < 7) { ld8f(p.st_pool + ((size_t)bq * 15 + 8 + t) * 512 + c, tmp); st8f(p.out + O_NPS + ((size_t)bq * 15 + t) * 512 + c, tmp); }
            }
        } else {
            const int c = (v - 64) * 8;
            float gb[8], gc[8], hv[8], v0[8], v1[8], v2[8], w0[8], w1[8], w2[8];
            const bf16_t* zr = zb + (size_t)r * INW + c;
            ld8(zr + 512, gb); ld8(zr + 1024, gc); ld8(zr + 1536, hv);
#pragma unroll
            for (int e = 0; e < 8; ++e) v2[e] = gc[e] * hv[e];
            if (t >= 1) { ld8(zr - INW + 1024, gc); ld8(zr - INW + 1536, hv);
#pragma unroll
                for (int e = 0; e < 8; ++e) v1[e] = gc[e] * hv[e]; }
            else if (samp) ld8f(p.st_conv + ((size_t)bq * 2 + 1) * 512 + c, v1);
            else {
#pragma unroll
                for (int e = 0; e < 8; ++e) v1[e] = 0.f; }
            if (t >= 2) { ld8(zr - 2 * INW + 1024, gc); ld8(zr - 2 * INW + 1536, hv);
#pragma unroll
                for (int e = 0; e < 8; ++e) v0[e] = gc[e] * hv[e]; }
            else if (samp) ld8f(p.st_conv + ((size_t)bq * 2 + t) * 512 + c, v0);
            else {
#pragma unroll
                for (int e = 0; e < 8; ++e) v0[e] = 0.f; }
            ld8f(p.conv_w + c, w0); ld8f(p.conv_w + 512 + c, w1); ld8f(p.conv_w + 1024 + c, w2);
            float y[8];
#pragma unroll
            for (int e = 0; e < 8; ++e) y[e] = gb[e] * (w0[e] * v0[e] + w1[e] * v1[e] + w2[e] * v2[e]);
            *(u32x4*)(A2 + (size_t)r * DM + 512 + c) = pack8(y);
            if (!samp) { if (t >= SEQL - 2) st8f(p.out + O_NCP + ((size_t)bq * 2 + (t - (SEQL - 2))) * 512 + c, v2); }
            else if (t >= 6) st8f(p.out + O_NCS + ((size_t)bq * 2 + (t - 6)) * 512 + c, v2);
        }
    }
}

__device__ __forceinline__ void fixup_rows(const Params& p, int pm, int tid) {
    if (tid >= FF / 8) return;
    const int f0 = tid * 8;
    const float* edge = (const float*)(p.ws + WS_EDGE) + (size_t)(pm - 1) * 2 * FF2 + f0;
    const float* first = (const float*)(p.ws + WS_FIRST) + (size_t)pm * 2 * FF2 + f0;
    bf16_t* actb = (bf16_t*)(p.ws + WS_ACT) + (size_t)pm * BM * FF + f0;
    float act0[8], act1[8];
    float ca0[8], ca1[8];
#pragma unroll
    for (int h = 0; h < 2; ++h) {
        float e0[8], e1[8], x0[8], x1[8], w0[8], w1[8], w2[8];
        ld8f(edge + h * FF, e0); ld8f(edge + FF2 + h * FF, e1); ld8f(first + h * FF, x0); ld8f(first + FF2 + h * FF, x1);
        ld8f(p.ffn_cw + h * FF + f0, w0); ld8f(p.ffn_cw + FF2 + h * FF + f0, w1); ld8f(p.ffn_cw + 2 * FF2 + h * FF + f0, w2);
#pragma unroll
        for (int e = 0; e < 8; ++e) {
            const float c0 = w0[e] * e0[e] + w1[e] * e1[e] + w2[e] * x0[e];
            const float c1 = w0[e] * e1[e] + w1[e] * x0[e] + w2[e] * x1[e];
            if (h == 0) { ca0[e] = c0; ca1[e] = c1; }
            else {
                act0[e] = ca0[e] * __builtin_amdgcn_rcpf(1.0f + __builtin_amdgcn_exp2f(ca0[e] * -1.44269504f)) * c0;
                act1[e] = ca1[e] * __builtin_amdgcn_rcpf(1.0f + __builtin_amdgcn_exp2f(ca1[e] * -1.44269504f)) * c1;
            }
        }
    }
    *(u32x4*)(actb) = pack8(act0); *(u32x4*)(actb + FF) = pack8(act1);
}

__device__ __forceinline__ void phase6(const Params& p) {
    const float* ss3 = (const float*)(p.ws + WS_SS) + NTOK;
    const int total = NTOK * 256;
    for (int it = blockIdx.x * 512 + threadIdx.x; it < total; it += gridDim.x * 512) {
        const int r = it >> 8, c4 = it & 255;
        const float rstd = rsqrtf(ss3[r] * (1.0f / DM) + EPS);
        f32x4* px = (f32x4*)(p.out + (size_t)r * DM) + c4;
        const f32x4 g = ((const f32x4*)p.gf)[c4];
        f32x4 v = *px; v = v * rstd * g; *px = v;
    }
}

template <int PH>
__device__ __forceinline__ void run_phase(const Params& p, LAS unsigned char* lds) {
    StaticOrder S;
    if (PH == 0) phase0(p, lds);
    if (PH == 1) { Gemm g{(const bf16_t*)(p.ws + WS_HB), (const bf16_t*)(p.ws + WS_WIN), NTOK, INW, DM}; S.init(NTOK, INW, gridDim.x, blockIdx.x);
        EpiZ E{(bf16_t*)(p.ws + WS_ZB), INW}; gemm_phase(lds, g, S, E); }
    if (PH == 2) phase2(p);
    if (PH == 3) { Gemm g{(const bf16_t*)(p.ws + WS_A2), (const bf16_t*)(p.ws + WS_WOUT), NTOK, DM, DM}; S.init(NTOK, DM, gridDim.x, blockIdx.x);
        EpiRes E{p.x_prompt, p.x_sample, p.out, (bf16_t*)(p.ws + WS_X1B), (float*)(p.ws + WS_SS)}; gemm_phase(lds, g, S, E); }
    if (PH == 4) { Gemm g{(const bf16_t*)(p.ws + WS_X1B), (const bf16_t*)(p.ws + WS_WUP), NTOK, FF2, DM}; S.init(NTOK, FF2, gridDim.x, blockIdx.x);
        EpiUp E{(const float*)(p.ws + WS_SS), p.ffn_cw, p.st_ffn, (bf16_t*)(p.ws + WS_ACT), (float*)(p.ws + WS_EDGE), (float*)(p.ws + WS_FIRST), p.out + O_NFP, p.out + O_NFS}; gemm_phase(lds, g, S, E); }
    if (PH == 5) { Gemm g{(const bf16_t*)(p.ws + WS_ACT), (const bf16_t*)(p.ws + WS_WDN), NTOK, DM, FF}; S.init(NTOK, DM, gridDim.x, blockIdx.x);
        { Unit u; for (int i = 0; S.next(i, u); ++i) if (u.pm < 64 && (u.pm & 7) != 0) fixup_rows(p, u.pm, threadIdx.x); }
        __threadfence(); __syncthreads();
        EpiRes E{p.out, p.out + (size_t)NPR * DM, p.out, nullptr, (float*)(p.ws + WS_SS) + NTOK}; gemm_phase(lds, g, S, E); }
    if (PH == 6) phase6(p);
}

extern __shared__ __attribute__((aligned(16))) unsigned char g_shm[];

template <int PH> __global__ __launch_bounds__(512, 2) void k_phase(Params p) { run_phase<PH>(p, (LAS unsigned char*)g_shm); }

#if !MULTI_LAUNCH
__global__ __launch_bounds__(512, 2) void k_mega(Params p) {
    cg::grid_group grid = cg::this_grid();
    LAS unsigned char* lds = (LAS unsigned char*)g_shm;
    run_phase<0>(p, lds); grid.sync();
    run_phase<1>(p, lds); grid.sync();
    run_phase<2>(p, lds); grid.sync();
    run_phase<3>(p, lds); grid.sync();
    run_phase<4>(p, lds); grid.sync();
    run_phase<5>(p, lds); grid.sync();
    run_phase<6>(p, lds);
}
#endif

extern "C" void kernel_launch(void* const* d_in, const int* in_sizes, int n_in, void* d_out, int out_size, void* d_ws, size_t ws_size, hipStream_t stream) {
    static int grid = 0;
    if (grid == 0) {
        int dev = 0, cus = 0, per_cu = 0;
        hipGetDevice(&dev);
        hipDeviceGetAttribute(&cus, hipDeviceAttributeMultiprocessorCount, dev);
#if MULTI_LAUNCH
        hipFuncSetAttribute((const void*)k_phase<0>, hipFuncAttributeMaxDynamicSharedMemorySize, LDS_BYTES);
        hipFuncSetAttribute((const void*)k_phase<1>, hipFuncAttributeMaxDynamicSharedMemorySize, LDS_BYTES);
        hipFuncSetAttribute((const void*)k_phase<2>, hipFuncAttributeMaxDynamicSharedMemorySize, LDS_BYTES);
        hipFuncSetAttribute((const void*)k_phase<3>, hipFuncAttributeMaxDynamicSharedMemorySize, LDS_BYTES);
        hipFuncSetAttribute((const void*)k_phase<4>, hipFuncAttributeMaxDynamicSharedMemorySize, LDS_BYTES);
        hipFuncSetAttribute((const void*)k_phase<5>, hipFuncAttributeMaxDynamicSharedMemorySize, LDS_BYTES);
        hipFuncSetAttribute((const void*)k_phase<6>, hipFuncAttributeMaxDynamicSharedMemorySize, LDS_BYTES);
        per_cu = 1;
#else
        hipFuncSetAttribute((const void*)k_mega, hipFuncAttributeMaxDynamicSharedMemorySize, LDS_BYTES);
        if (hipOccupancyMaxActiveBlocksPerMultiprocessor(&per_cu, (const void*)k_mega, 512, LDS_BYTES) != hipSuccess || per_cu < 1) {
            fprintf(stderr, "kernel_launch: occupancy query says %d blocks per CU\n", per_cu); per_cu = 1; }
        if (per_cu > 1) per_cu = 1;
#endif
        (void)hipGetLastError();
        grid = cus * per_cu;
        if (ws_size < 200 * MiB) fprintf(stderr, "kernel_launch: workspace too small (%zu)\n", ws_size);
    }
    Params p{};
    p.x_prompt = (const float*)d_in[0]; p.x_sample = (const float*)d_in[1]; p.st_pool = (const float*)d_in[2]; p.st_conv = (const float*)d_in[3]; p.st_ffn = (const float*)d_in[4];
    p.g1 = (const float*)d_in[5]; p.w_in = (const float*)d_in[6]; p.w_grp = (const float*)d_in[7]; p.pool_scale = (const float*)d_in[8]; p.conv_w = (const float*)d_in[9];
    p.w_out = (const float*)d_in[10]; p.g2 = (const float*)d_in[11]; p.w_up = (const float*)d_in[12]; p.ffn_cw = (const float*)d_in[13]; p.w_down = (const float*)d_in[14]; p.gf = (const float*)d_in[15];
    p.out = (float*)d_out; p.ws = (unsigned char*)d_ws;
#if MULTI_LAUNCH
    hipLaunchKernelGGL(k_phase<0>, dim3(grid), dim3(512), LDS_BYTES, stream, p);
    hipLaunchKernelGGL(k_phase<1>, dim3(grid), dim3(512), LDS_BYTES, stream, p);
    hipLaunchKernelGGL(k_phase<2>, dim3(grid), dim3(512), LDS_BYTES, stream, p);
    hipLaunchKernelGGL(k_phase<3>, dim3(grid), dim3(512), LDS_BYTES, stream, p);
    hipLaunchKernelGGL(k_phase<4>, dim3(grid), dim3(512), LDS_BYTES, stream, p);
    hipLaunchKernelGGL(k_phase<5>, dim3(grid), dim3(512), LDS_BYTES, stream, p);
    hipLaunchKernelGGL(k_phase<6>, dim3(grid), dim3(512), LDS_BYTES, stream, p);
#else
    void* args[] = {&p};
    hipError_t e = hipLaunchCooperativeKernel((const void*)k_mega, dim3(grid), dim3(512), args, LDS_BYTES, stream);
    if (e != hipSuccess) fprintf(stderr, "cooperative launch failed: %s (grid %d)\n", hipGetErrorString(e), grid);
#endif
}
```

```cpp
#include <hip/hip_runtime.h>
#include <hip/hip_cooperative_groups.h>
#include <hip/amd_detail/amd_hip_unsafe_atomics.h>
#include <cstdio>
namespace cg = cooperative_groups;

#ifndef MULTI_LAUNCH
#define MULTI_LAUNCH 0
#endif
#ifndef P5_SPLIT
#define P5_SPLIT 1
#endif
#ifndef DUP_PHASE
#define DUP_PHASE -1
#endif

#define LAS __attribute__((address_space(3)))
typedef unsigned short bf16_t;
typedef short bf16x8 __attribute__((ext_vector_type(8)));
typedef float f32x4 __attribute__((ext_vector_type(4)));
typedef unsigned u32x4 __attribute__((ext_vector_type(4)));
typedef unsigned u32x2 __attribute__((ext_vector_type(2)));

constexpr int NTOK = 17408, NPR = 16384, DM = 1024, INW = 2048, FF = 2816, FF2 = 5632;
constexpr int ZP = 1536;
constexpr int SEQL = 2048;
constexpr float EPS = 1e-6f;

constexpr size_t MiB = 1u << 20;
constexpr size_t WS_WIN = 0, WS_WOUT = 4 * MiB, WS_WUP = 6 * MiB, WS_WDN = 17 * MiB, WS_SS = 23 * MiB, WS_BAR = 23 * MiB + 512 * 1024, WS_RINV = 23 * MiB + 256 * 1024, WS_CNT = 23 * MiB + 160 * 1024, WS_EDGE = 24 * MiB, WS_FIRST = 27 * MiB,
                 WS_HB = 30 * MiB, WS_ZB = 64 * MiB, WS_A2 = 132 * MiB, WS_X1B = 166 * MiB, WS_ACT = 30 * MiB, WS_PART = 132 * MiB, WS_X2B = 200 * MiB;
constexpr size_t O_Y = 0, O_NPP = 17825792, O_NCP = 17887232, O_NFP = 17895424, O_NPS = 17985536, O_NCS = 18968576, O_NFS = 19099648;

struct Params {
    const float *x_prompt, *x_sample, *st_pool, *st_conv, *st_ffn, *g1, *w_in, *w_grp, *pool_scale, *conv_w, *w_out, *g2, *w_up, *ffn_cw, *w_down, *gf;
    float* out; unsigned char* ws;
};

constexpr int BM = 256, BK = 64, HALF = 128, HTB = HALF * BK * 2, STAGE_BYTES = 8 * HTB, NXCD = 8, WGM = 8;
constexpr int XCH_BYTES = 8192, RT_OFF = STAGE_BYTES + XCH_BYTES + 16, TAB_OFF = RT_OFF + 1024, TAB_BYTES = 4096, LDS_BYTES = TAB_OFF + 2 * TAB_BYTES;

__device__ __forceinline__ int lds_byte(int r, int c) { const int st = (r >> 4) * 2 + (c >> 5), rr = r & 15, cc = c & 31, ob = rr * 64 + cc * 2; return st * 1024 + (ob ^ (((ob >> 9) & 1) << 5)); }
__device__ __forceinline__ void stage_rc(int b, int& R, int& C) { const int st = b / 1024, sb = b % 1024, swz = sb ^ (((sb >> 9) & 1) << 5); R = (st >> 1) * 16 + swz / 64; C = (st & 1) * 32 + (swz % 64) / 2; }
__device__ __forceinline__ int perm32(int rho) { const int n = rho >> 4, i = rho & 15; return 8 * (i >> 2) + 4 * n + (i & 3); }

struct Unit { int pm, pn, kt0, nkt; };
struct Gemm { const bf16_t* A; const bf16_t* Bt; int M, N, K; };

struct StaticOrder {
    int nM, nN, nwg, G, c, nkt, split, spm, spn;
    __device__ void init(int M, int N, int K, int G_, int c_, int split_) { nM = M / BM; nN = N / BM; nwg = nM * nN; G = G_; c = c_; nkt = K / BK; split = split_; }
    __device__ void tile(int L, Unit& u) const {
        if (split) { if (L < 256) { u.pm = 8 * (L & 7) + ((L >> 3) & 7); u.pn = L >> 6; } else { u.pm = 64 + ((L - 256) >> 2); u.pn = (L - 256) & 3; } return; }
        int wgid = L; { const int q = nwg / NXCD, r = nwg % NXCD, xcd = wgid % NXCD, off = wgid / NXCD; wgid = (xcd < r ? xcd * (q + 1) : r * (q + 1) + (xcd - r) * q) + off; }
        const int nig = WGM * nN, gid = wgid / nig, fm = gid * WGM, gsz = (nM - fm) < WGM ? (nM - fm) : WGM;
        u.pm = fm + ((wgid % nig) % gsz); u.pn = (wgid % nig) / gsz;
    }
    __device__ bool next(int i, Unit& u) const {
        if (split == 2) { if (i) return false; u.pm = spm; u.pn = spn; u.kt0 = 0; u.nkt = nkt; return true; }
        if (split && i >= 1) {
            const int s = c; if (i > 1 || s >= 8 * (nwg - G)) return false;
            tile(G + (s >> 3), u); const int ks = s & 7; u.kt0 = ks < 6 ? 6 * ks : 36 + 4 * (ks - 6); u.nkt = ks < 6 ? 6 : 4; return true;
        }
        const long L = (long)i * G + c; if (L >= nwg) return false;
        tile((int)L, u); u.kt0 = 0; u.nkt = nkt; return true;
    }
    __device__ int count() const { Unit u; int n = 0; while (next(n, u)) ++n; return n; }
};

__device__ __forceinline__ unsigned cvt_pk_bf16(float lo, float hi) { unsigned r; asm("v_cvt_pk_bf16_f32 %0, %1, %2" : "=v"(r) : "v"(lo), "v"(hi)); return r; }
__device__ __forceinline__ float bf_lo(unsigned w) { return __uint_as_float(w << 16); }
__device__ __forceinline__ float bf_hi(unsigned w) { return __uint_as_float(w & 0xffff0000u); }
__device__ __forceinline__ void unpack8(const u32x4 w, float (&f)[8]) { f[0] = bf_lo(w.x); f[1] = bf_hi(w.x); f[2] = bf_lo(w.y); f[3] = bf_hi(w.y); f[4] = bf_lo(w.z); f[5] = bf_hi(w.z); f[6] = bf_lo(w.w); f[7] = bf_hi(w.w); }
__device__ __forceinline__ u32x4 pack8(const float (&f)[8]) { u32x4 w; w.x = cvt_pk_bf16(f[0], f[1]); w.y = cvt_pk_bf16(f[2], f[3]); w.z = cvt_pk_bf16(f[4], f[5]); w.w = cvt_pk_bf16(f[6], f[7]); return w; }
__device__ __forceinline__ float wave_sum(float v) {
#pragma unroll
    for (int o = 1; o < 64; o <<= 1) v += __shfl_xor(v, o);
    return v;
}
__device__ __forceinline__ int opaque_tid(int wv) { int l; asm volatile("v_mbcnt_lo_u32_b32 %0, -1, 0\n\tv_mbcnt_hi_u32_b32 %0, -1, %0" : "=v"(l)); return wv * 64 + l; }
template <int CTRL> __device__ __forceinline__ float dppf(float v) { return __int_as_float(__builtin_amdgcn_update_dpp(0, __float_as_int(v), CTRL, 0xf, 0xf, true)); }


#define XB_TMO      128
#define XB_XCNT(j)  (256  + 64 * (j))
#define XB_XSUB(j)  (1280 + 64 * (j))
#define XB_XGEN(j)  (2304 + 64 * (j))
#define XB_TOP      3328
#define XB_TOPGEN   3392
#define XCD_BAR_WORDS 3456
#define XB_SPIN_CAP (1u << 18)
__device__ __forceinline__ unsigned xb_ld(unsigned* p)              { return __hip_atomic_load(p, __ATOMIC_RELAXED, __HIP_MEMORY_SCOPE_AGENT); }
__device__ __forceinline__ unsigned xb_add(unsigned* p, unsigned v) { return __hip_atomic_fetch_add(p, v, __ATOMIC_RELAXED, __HIP_MEMORY_SCOPE_AGENT); }
__device__ __forceinline__ unsigned xb_xcc_id() { return (unsigned)__builtin_amdgcn_s_getreg((3 << 11) | 20) & 0xFu; }
#define XB_SPIN(cond, bar) do { unsigned _sp = 0; while (cond) { __builtin_amdgcn_s_sleep(1); \
    if ((++_sp & 255u) == 0u) { if (xb_ld(&(bar)[XB_TMO])) break; if (_sp > XB_SPIN_CAP) { atomicAdd(&(bar)[XB_TMO], 1u); break; } } } } while (0)
struct XcdBarrier { unsigned* bar; unsigned x; volatile LAS unsigned* st; };
__device__ __forceinline__ XcdBarrier xcd_barrier_post(unsigned* bar, volatile LAS unsigned* st, int tid) {
    XcdBarrier b; b.bar = bar; b.x = xb_xcc_id(); b.st = st;
    if (tid == 0) (void)xb_add(&bar[XB_XCNT(b.x)], 1u);
    return b;
}
__device__ __forceinline__ void xcd_barrier_complete(unsigned* bar, unsigned x, unsigned& nloc, unsigned& nx) {
    const unsigned G = gridDim.x * gridDim.y * gridDim.z;
    unsigned sum, cnt, mine, sp = 0u;
    for (;;) {
        sum = 0u; cnt = 0u; mine = 0u;
#pragma unroll
        for (unsigned j = 0; j < 16; ++j) { const unsigned c = xb_ld(&bar[XB_XCNT(j)]); sum += c; cnt += (c > 0u) ? 1u : 0u; mine = (j == x) ? c : mine; }
        if (sum == G) break;
        __builtin_amdgcn_s_sleep(1);
        if ((++sp & 255u) == 0u) { if (xb_ld(&bar[XB_TMO])) break; if (sp > XB_SPIN_CAP) { atomicAdd(&bar[XB_TMO], 1u); break; } }
    }
    nloc = mine > 0u ? mine : 1u; nx = cnt > 0u ? cnt : 1u;
}
__device__ __forceinline__ void xcd_barrier(const XcdBarrier& b, int wv) {
    asm volatile("s_waitcnt vmcnt(0)" ::: "memory");
    __syncthreads();
    if (opaque_tid(wv) == 0) {
        unsigned* bar = b.bar;
        __builtin_amdgcn_s_waitcnt(0);
        unsigned nloc = b.st[0], nx = b.st[1];
        if (nloc == 0u) { xcd_barrier_complete(bar, b.x, nloc, nx); b.st[0] = nloc; b.st[1] = nx; }
        const unsigned old = xb_add(&bar[XB_XSUB(b.x)], 1u);
        const unsigned gen = old / nloc;
        if (old + 1u == (gen + 1u) * nloc) {
            __builtin_amdgcn_fence(__ATOMIC_RELEASE, "agent");
            asm volatile("s_waitcnt vmcnt(0)" ::: "memory");
            const unsigned og = xb_add(&bar[XB_TOP], 1u);
            const unsigned tg = og / nx;
            if (og + 1u == (tg + 1u) * nx) xb_add(&bar[XB_TOPGEN], 1u);
            else XB_SPIN(xb_ld(&bar[XB_TOPGEN]) == tg, bar);
            __builtin_amdgcn_fence(__ATOMIC_ACQUIRE, "agent");
            xb_add(&bar[XB_XGEN(b.x)], 1u);
            asm volatile("s_waitcnt vmcnt(0)" ::: "memory");
        } else {
            XB_SPIN(xb_ld(&bar[XB_XGEN(b.x)]) == gen, bar);
            __builtin_amdgcn_fence(__ATOMIC_ACQUIRE, "agent");
            asm volatile("s_waitcnt vmcnt(0)" ::: "memory");
        }
    }
    __syncthreads();
}

struct EpiZ {
    bf16_t* O; int ldc;
    __device__ __forceinline__ void prefetch(LAS unsigned char*, const Unit&, int, int, int) const {}
    __device__ __forceinline__ void operator()(const f32x4 (&acc)[2][2][4][2], const Unit& u, int wr, int wc, int fr, int fq, LAS unsigned char*, int, bool, const Unit&) const {
        const int row0 = u.pm * BM + wr * 64 + fr, col0 = u.pn * BM + wc * 32 + 8 * fq;
        if (u.pn >= 4) {
            const int colv = 1024 + (u.pn - 4) * 128 + wc * 32 + 8 * fq;
#pragma unroll
            for (int ai = 0; ai < 2; ++ai)
#pragma unroll
                for (int m = 0; m < 4; ++m) { const f32x4 v0 = acc[ai][0][m][0] * acc[ai][1][m][0], v1 = acc[ai][0][m][1] * acc[ai][1][m][1];
                    u32x4 w; w.x = cvt_pk_bf16(v0[0], v0[1]); w.y = cvt_pk_bf16(v0[2], v0[3]); w.z = cvt_pk_bf16(v1[0], v1[1]); w.w = cvt_pk_bf16(v1[2], v1[3]);
                    *(u32x4*)(O + (size_t)(row0 + ai * HALF + m * 16) * ldc + colv) = w; }
            return;
        }
#pragma unroll
        for (int ai = 0; ai < 2; ++ai)
#pragma unroll
            for (int m = 0; m < 4; ++m) { bf16_t* rowp = O + (size_t)(row0 + ai * HALF + m * 16) * ldc + col0;
#pragma unroll
                for (int bj = 0; bj < 2; ++bj) { const f32x4 v0 = acc[ai][bj][m][0], v1 = acc[ai][bj][m][1];
                    u32x4 w; w.x = cvt_pk_bf16(v0[0], v0[1]); w.y = cvt_pk_bf16(v0[2], v0[3]); w.z = cvt_pk_bf16(v1[0], v1[1]); w.w = cvt_pk_bf16(v1[2], v1[3]);
                    *(u32x4*)(rowp + bj * HALF) = w; } }
    }
};
template <bool RES_BF16>
struct EpiRes {
    const float* rscale; const bf16_t* rb; bf16_t* xb; float* ss; int full_nkt; float* part;
    __device__ __forceinline__ void prefetch(LAS unsigned char*, const Unit&, int, int, int) const {}
    __device__ __forceinline__ void operator()(const f32x4 (&acc)[2][2][4][2], const Unit& u, int wr, int wc, int fr, int fq, LAS unsigned char*, int, bool, const Unit&) const {
        const int row0 = u.pm * BM + wr * 64 + fr, col0 = u.pn * BM + wc * 32 + 8 * fq;
        if (u.nkt != full_nkt) {
            const int ks = u.kt0 < 36 ? u.kt0 / 6 : 6 + (u.kt0 - 36) / 4;
#pragma unroll
            for (int ai = 0; ai < 2; ++ai)
#pragma unroll
                for (int m = 0; m < 4; ++m) { float* dst = part + ((size_t)ks * 1024 + (row0 - NPR + ai * HALF + m * 16)) * DM + col0;
#pragma unroll
                    for (int bj = 0; bj < 2; ++bj)
#pragma unroll
                        for (int n = 0; n < 2; ++n) *(f32x4*)(dst + bj * HALF + n * 4) = acc[ai][bj][m][n]; }
            return;
        }
#pragma unroll
        for (int ai = 0; ai < 2; ++ai) {
            f32x4 rr[4][2][2];
#pragma unroll
            for (int m = 0; m < 4; ++m) {
                const float sc = RES_BF16 ? 1.0f : rscale[row0 + ai * HALF + m * 16];
#pragma unroll
                for (int bj = 0; bj < 2; ++bj) {
                    const u32x4 w = *(const u32x4*)(rb + (size_t)(row0 + ai * HALF + m * 16) * DM + col0 + bj * HALF);
                    rr[m][bj][0] = (f32x4){bf_lo(w.x), bf_hi(w.x), bf_lo(w.y), bf_hi(w.y)}; rr[m][bj][1] = (f32x4){bf_lo(w.z), bf_hi(w.z), bf_lo(w.w), bf_hi(w.w)};
                    if (!RES_BF16) { rr[m][bj][0] = rr[m][bj][0] * sc; rr[m][bj][1] = rr[m][bj][1] * sc; } } }
#pragma unroll
            for (int m = 0; m < 4; ++m) {
                const int row = row0 + ai * HALF + m * 16;
                float q = 0.f;
#pragma unroll
                for (int bj = 0; bj < 2; ++bj) {
                    const f32x4 v0 = acc[ai][bj][m][0] + rr[m][bj][0], v1 = acc[ai][bj][m][1] + rr[m][bj][1];
                    u32x4 w; w.x = cvt_pk_bf16(v0[0], v0[1]); w.y = cvt_pk_bf16(v0[2], v0[3]); w.z = cvt_pk_bf16(v1[0], v1[1]); w.w = cvt_pk_bf16(v1[2], v1[3]);
                    *(u32x4*)(xb + (size_t)row * DM + col0 + bj * HALF) = w;
                    q += (v0[0] * v0[0] + v0[1] * v0[1]) + (v0[2] * v0[2] + v0[3] * v0[3]) + (v1[0] * v1[0] + v1[1] * v1[1]) + (v1[2] * v1[2] + v1[3] * v1[3]);
                }
                if (!RES_BF16) { q += __shfl_xor(q, 16); q += __shfl_xor(q, 32); if (fq == 0) atomicAdd(ss + row, q); }
            }
        }
    }
};

struct EpiDownFused {
    const bf16_t* rb; float* yout; const float* gf; float* ss3; unsigned* cnt; int full_nkt; float* part;
    __device__ __forceinline__ void prefetch(LAS unsigned char*, const Unit&, int, int, int) const {}
    __device__ __forceinline__ void operator()(f32x4 (&acc)[2][2][4][2], const Unit& u, int wr, int wc, int fr, int fq, LAS unsigned char*, int, bool, const Unit&) const {
        const int row0 = u.pm * BM + wr * 64 + fr, col0 = u.pn * BM + wc * 32 + 8 * fq;
        if (u.nkt != full_nkt) {
            const int ks = u.kt0 < 36 ? u.kt0 / 6 : 6 + (u.kt0 - 36) / 4;
#pragma unroll
            for (int ai = 0; ai < 2; ++ai)
#pragma unroll
                for (int m = 0; m < 4; ++m) { float* dst = part + ((size_t)ks * 1024 + (row0 - NPR + ai * HALF + m * 16)) * DM + col0;
#pragma unroll
                    for (int bj = 0; bj < 2; ++bj)
#pragma unroll
                        for (int n = 0; n < 2; ++n) *(f32x4*)(dst + bj * HALF + n * 4) = acc[ai][bj][m][n]; }
            return;
        }
#pragma unroll
        for (int ai = 0; ai < 2; ++ai) {
            u32x4 rw[4][2];
#pragma unroll
            for (int m = 0; m < 4; ++m)
#pragma unroll
                for (int bj = 0; bj < 2; ++bj) rw[m][bj] = *(const u32x4*)(rb + (size_t)(row0 + ai * HALF + m * 16) * DM + col0 + bj * HALF);
#pragma unroll
            for (int m = 0; m < 4; ++m) {
                float q = 0.f;
#pragma unroll
                for (int bj = 0; bj < 2; ++bj) { const u32x4 w = rw[m][bj];
                    const f32x4 v0 = acc[ai][bj][m][0] + (f32x4){bf_lo(w.x), bf_hi(w.x), bf_lo(w.y), bf_hi(w.y)}, v1 = acc[ai][bj][m][1] + (f32x4){bf_lo(w.z), bf_hi(w.z), bf_lo(w.w), bf_hi(w.w)};
                    acc[ai][bj][m][0] = v0; acc[ai][bj][m][1] = v1;
                    q += (v0[0] * v0[0] + v0[1] * v0[1]) + (v0[2] * v0[2] + v0[3] * v0[3]) + (v1[0] * v1[0] + v1[1] * v1[1]) + (v1[2] * v1[2] + v1[3] * v1[3]); }
                q += __shfl_xor(q, 16); q += __shfl_xor(q, 32);
                if (fq == 0) atomicAdd(ss3 + row0 + ai * HALF + m * 16, q);
            }
        }
        asm volatile("s_waitcnt vmcnt(0)" ::: "memory"); __builtin_amdgcn_s_barrier(); asm volatile("" ::: "memory");
        if (wr == 0 && wc == 0) {
            unsigned* c4 = cnt + 64 * u.pm;
            if (fr == 0 && fq == 0) __hip_atomic_fetch_add(c4, 1u, __ATOMIC_RELAXED, __HIP_MEMORY_SCOPE_AGENT);
            unsigned polls = 0;
            while ((unsigned)__builtin_amdgcn_readfirstlane(__hip_atomic_load(c4, __ATOMIC_RELAXED, __HIP_MEMORY_SCOPE_AGENT)) < 4u) { __builtin_amdgcn_s_sleep(2); if (++polls > (1u << 17)) break; }
        }
        asm volatile("" ::: "memory"); __builtin_amdgcn_s_barrier(); asm volatile("" ::: "memory");
        f32x4 g[2][2];
#pragma unroll
        for (int bj = 0; bj < 2; ++bj) { g[bj][0] = *(const f32x4*)(gf + col0 + bj * HALF); g[bj][1] = *(const f32x4*)(gf + col0 + bj * HALF + 4); }
#pragma unroll
        for (int ai = 0; ai < 2; ++ai)
#pragma unroll
            for (int m = 0; m < 4; ++m) {
                const int row = row0 + ai * HALF + m * 16;
                const float rstd = rsqrtf(__hip_atomic_load(ss3 + row, __ATOMIC_RELAXED, __HIP_MEMORY_SCOPE_AGENT) * (1.0f / DM) + EPS);
                float* dst = yout + (size_t)row * DM + col0;
#pragma unroll
                for (int bj = 0; bj < 2; ++bj) { *(f32x4*)(dst + bj * HALF) = acc[ai][bj][m][0] * rstd * g[bj][0]; *(f32x4*)(dst + bj * HALF + 4) = acc[ai][bj][m][1] * rstd * g[bj][1]; }
            }
    }
};

__device__ __forceinline__ float conv_dpp(float acc0, float x, float w1, float w0, float p, float w1m, float w0m) {
    asm("s_nop 1\n\t"
        "v_fmac_f32_dpp %0, %1, %2 row_shr:1 row_mask:0xf bank_mask:0xf bound_ctrl:1\n\t"
        "v_fmac_f32_dpp %0, %1, %3 row_shr:2 row_mask:0xf bank_mask:0xf bound_ctrl:1\n\t"
        "v_fmac_f32_dpp %0, %4, %5 row_ror:1 row_mask:0xf bank_mask:0xf bound_ctrl:1\n\t"
        "v_fmac_f32_dpp %0, %4, %6 row_ror:2 row_mask:0xf bank_mask:0xf bound_ctrl:1"
        : "+v"(acc0) : "v"(x), "v"(w1), "v"(w0), "v"(p), "v"(w1m), "v"(w0m));
    return acc0;
}
__device__ __forceinline__ float conv_dpp2(float acc0, float x, float w1i, float w0i) {
    asm("s_nop 1\n\t"
        "v_fmac_f32_dpp %0, %1, %2 row_shr:1 row_mask:0xf bank_mask:0xf bound_ctrl:1\n\t"
        "v_fmac_f32_dpp %0, %1, %3 row_shr:2 row_mask:0xf bank_mask:0xf bound_ctrl:1"
        : "+v"(acc0) : "v"(x), "v"(w1i), "v"(w0i));
    return acc0;
}
typedef float f32x2 __attribute__((ext_vector_type(2)));
__device__ __forceinline__ f32x2 silu_gate_pk(f32x2 ca, f32x2 cb) {
    const f32x2 t = ca * -1.44269504f; f32x2 e; e.x = __builtin_amdgcn_exp2f(t.x); e.y = __builtin_amdgcn_exp2f(t.y);
    const f32x2 d = e + 1.0f; f32x2 s; s.x = __builtin_amdgcn_rcpf(d.x); s.y = __builtin_amdgcn_rcpf(d.y);
    return (ca * s) * cb;
}
struct EpiUp {
    const float* ss2; const float* cw; const float* st_ffn; bf16_t* actb; float* edge; float* first; float* nfp; float* nfs;

    __device__ __forceinline__ void prefetch(LAS unsigned char* lds, const Unit& u, int par, int wid, int) const {
        int lane; asm volatile("v_mbcnt_lo_u32_b32 %0, -1, 0\n\tv_mbcnt_hi_u32_b32 %0, -1, %0" : "=v"(lane));
        LAS unsigned char* tab = lds + TAB_OFF + par * TAB_BYTES;
        if (wid < 4) __builtin_amdgcn_global_load_lds((const unsigned*)(ss2 + u.pm * BM + wid * 64 + lane), (LAS unsigned*)(tab + wid * 256), 4, 0, 0);
        else if (wid < 7) { const int j = wid - 4, h = lane >> 5, i = lane & 31;
            __builtin_amdgcn_global_load_lds((const unsigned*)(cw + j * FF2 + h * FF + u.pn * 128 + 4 * i), (LAS unsigned*)(tab + 1024 + j * 1024), 16, 0, 0); }
    }
    template <bool SAMPLE>
    __device__ __forceinline__ void body(const f32x4 (&acc)[2][2][4][2], const Unit& u, int wr, int wc, int fr, int fq, LAS unsigned char* lds, int par) const {
        const int wid = wr * 4 + wc;
        const int f0 = u.pn * 128 + wc * 32 + 8 * fq;
        const int rowb = u.pm * BM + wr * 64 + fr;
        LAS float* xch = (LAS float*)(lds + STAGE_BYTES);
        LAS float* rtab = (LAS float*)(lds + RT_OFF);
        const LAS float* raw = (const LAS float*)(lds + TAB_OFF + par * TAB_BYTES);
        const LAS float* wt = raw + 256;
        if (wr == 0) { const int t = wc * 64 + fq * 16 + fr; rtab[t] = rsqrtf(raw[t] * (1.0f / DM) + EPS); }
        if (!SAMPLE) {
            if (fr >= 14) {
#pragma unroll
                for (int ai = 0; ai < 2; ++ai) {
                    LAS float* dst = xch + ((((wid * 2 + ai) * 4 + fq) * 2 + (fr - 14)) * 16);
                    const float r = rsqrtf(raw[wr * 64 + fr + ai * HALF + 48] * (1.0f / DM) + EPS);
#pragma unroll
                    for (int bj = 0; bj < 2; ++bj)
#pragma unroll
                        for (int n = 0; n < 2; ++n) *(LAS f32x4*)(dst + bj * 8 + n * 4) = acc[ai][bj][3][n] * r;
                }
            }
        }
        asm volatile("s_waitcnt lgkmcnt(0)" ::: "memory"); __builtin_amdgcn_s_barrier(); asm volatile("" ::: "memory");
        const int s8 = fr & 7;
#pragma unroll
        for (int n = 0; n < 2; ++n) {
            const int fn = f0 + 4 * n;
            f32x4 wa[3], wb[3];
#pragma unroll
            for (int j = 0; j < 3; ++j) { wa[j] = *(const LAS f32x4*)(wt + (j * 2 + 0) * 128 + wc * 32 + 8 * fq + 4 * n); wb[j] = *(const LAS f32x4*)(wt + (j * 2 + 1) * 128 + wc * 32 + 8 * fq + 4 * n); }
            const f32x4 z4w = (f32x4){0.f, 0.f, 0.f, 0.f};
            const bool k1 = SAMPLE ? (s8 >= 1) : (fr == 0), k0 = SAMPLE ? (s8 >= 2) : (fr < 2);
            const f32x4 wa1m = k1 ? wa[1] : z4w, wa0m = k0 ? wa[0] : z4w, wb1m = k1 ? wb[1] : z4w, wb0m = k0 ? wb[0] : z4w;
            f32x4 pa, pb;
#pragma unroll
            for (int ai = 0; ai < 2; ++ai) {
                if (!SAMPLE) {
                    if (ai == 0 && wr == 0) { pa = (f32x4){0.f, 0.f, 0.f, 0.f}; pb = pa; }
                    else {
                        const int swid = ((wr ^ 1) << 2) | wc, sai = (ai == 1 && wr == 1) ? 1 : 0;
                        const LAS float* src = xch + ((((swid * 2 + sai) * 4 + fq) * 2 + (fr & 1)) * 16);
                        pa = *(const LAS f32x4*)(src + 4 * n); pb = *(const LAS f32x4*)(src + 8 + 4 * n);
                    }
                }
#pragma unroll
                for (int m = 0; m < 4; ++m) {
                    const int row = rowb + ai * HALF + m * 16;
                    const float r = rtab[wr * 64 + fr + ai * HALF + m * 16];
                    const f32x4 va = acc[ai][0][m][n] * r, vb = acc[ai][1][m][n] * r;
                    f32x4 b1a, b2a, b1b, b2b;
                    const f32x4 z4 = (f32x4){0.f, 0.f, 0.f, 0.f};
                    if (SAMPLE) {
                        const int bseq = (row - NPR) >> 3;
                        const float* h0 = st_ffn + (size_t)bseq * 2 * FF2 + fn; const float* h1 = h0 + FF2;
                        b1a = z4; b2a = z4; b1b = z4; b2b = z4;
                        if (s8 < 2) {
                            const f32x4 h1a = *(const f32x4*)(h1), h1b = *(const f32x4*)(h1 + FF);
                            if (s8 == 0) { b1a = h1a; b1b = h1b; b2a = *(const f32x4*)(h0); b2b = *(const f32x4*)(h0 + FF); }
                            else { b2a = h1a; b2b = h1b; }
                        }
                    }
                    float act[4];
                    if (SAMPLE) {
                        const f32x4 ca0 = wa[2] * va, cb0 = wb[2] * vb;
                        float ca[4], cb[4];
#pragma unroll
                        for (int e = 0; e < 4; ++e) {
                            ca[e] = conv_dpp2(ca0[e], va[e], wa1m[e], wa0m[e]); ca[e] = fmaf(wa[1][e], b1a[e], ca[e]); ca[e] = fmaf(wa[0][e], b2a[e], ca[e]);
                            cb[e] = conv_dpp2(cb0[e], vb[e], wb1m[e], wb0m[e]); cb[e] = fmaf(wb[1][e], b1b[e], cb[e]); cb[e] = fmaf(wb[0][e], b2b[e], cb[e]); }
                        const f32x2 r01 = silu_gate_pk((f32x2){ca[0], ca[1]}, (f32x2){cb[0], cb[1]}), r23 = silu_gate_pk((f32x2){ca[2], ca[3]}, (f32x2){cb[2], cb[3]});
                        act[0] = r01.x; act[1] = r01.y; act[2] = r23.x; act[3] = r23.y;
                    } else {
                        const f32x4 ca0 = wa[2] * va, cb0 = wb[2] * vb;
                        float ca[4], cb[4];
#pragma unroll
                        for (int e = 0; e < 4; ++e) { ca[e] = conv_dpp(ca0[e], va[e], wa[1][e], wa[0][e], pa[e], wa1m[e], wa0m[e]); cb[e] = conv_dpp(cb0[e], vb[e], wb[1][e], wb[0][e], pb[e], wb1m[e], wb0m[e]); }
                        const f32x2 r01 = silu_gate_pk((f32x2){ca[0], ca[1]}, (f32x2){cb[0], cb[1]}), r23 = silu_gate_pk((f32x2){ca[2], ca[3]}, (f32x2){cb[2], cb[3]});
                        act[0] = r01.x; act[1] = r01.y; act[2] = r23.x; act[3] = r23.y;
                    }
                    { u32x2 w; w.x = cvt_pk_bf16(act[0], act[1]); w.y = cvt_pk_bf16(act[2], act[3]);
                      *(u32x2*)(actb + (((size_t)u.pm * (FF / BK) + (fn >> 6)) * BM + (row & 255)) * BK + (fn & 63)) = w; }
                    if (SAMPLE) {
                        if (s8 >= 6) { float* d = nfs + ((size_t)((row - NPR) >> 3) * 2 + (s8 - 6)) * FF2 + fn; *(f32x4*)(d) = va; *(f32x4*)(d + FF) = vb; }
                    } else {
                        if (ai == 1 && wr == 1 && m == 3 && fr >= 14) {
                            float* d = edge + ((size_t)u.pm * 2 + (fr - 14)) * FF2 + fn; *(f32x4*)(d) = va; *(f32x4*)(d + FF) = vb;
                            if ((u.pm & 7) == 7) { float* d2 = nfp + ((size_t)(u.pm >> 3) * 2 + (fr - 14)) * FF2 + fn; *(f32x4*)(d2) = va; *(f32x4*)(d2 + FF) = vb; }
                        }
                        if (ai == 0 && wr == 0 && m == 0 && fr < 2) { float* d = first + ((size_t)u.pm * 2 + fr) * FF2 + fn; *(f32x4*)(d) = va; *(f32x4*)(d + FF) = vb; }
                        pa = va; pb = vb;
                    }
                    __builtin_amdgcn_sched_barrier(0);
                }
            }
        }
    }
    __device__ __forceinline__ void operator()(const f32x4 (&acc)[2][2][4][2], const Unit& u, int wr, int wc, int fr_, int fq_, LAS unsigned char* lds, int ui, bool has_next, const Unit& nxt) const {
        int lane; asm volatile("v_mbcnt_lo_u32_b32 %0, -1, 0\n\tv_mbcnt_hi_u32_b32 %0, -1, %0" : "=v"(lane));
        const int fr = lane & 15, fq = lane >> 4;
        if (has_next) prefetch(lds, nxt, (ui + 1) & 1, wr * 4 + wc, lane);
        if (u.pm >= 64) body<true>(acc, u, wr, wc, fr, fq, lds, ui & 1); else body<false>(acc, u, wr, wc, fr, fq, lds, ui & 1);
    }
};

template <class Epi, bool TILED = false>
__device__ __forceinline__ void gemm_phase(LAS unsigned char* lds, const Gemm g, const StaticOrder& S, const Epi& E, int wv) {
    const int tid = opaque_tid(wv), wid = __builtin_amdgcn_readfirstlane(tid >> 6), lane = tid & 63, wr = wid >> 2, wc = wid & 3, fr = lane & 15, fq = lane >> 4;
    const int K = g.K;
    unsigned voffA[2], voffB[2];
#pragma unroll
    for (int i = 0; i < 2; ++i) { int R, C; stage_rc(tid * 16 + i * 8192, R, C); const int Rb = (R & ~31) + perm32(R & 31);
        const int P = TILED ? BK : K;
        voffA[i] = (unsigned)(R * P + C) * 2u; voffB[i] = (unsigned)(Rb * P + C) * 2u; }
    const size_t kstep = TILED ? (size_t)(BM * BK * 2) : (size_t)(BK * 2);
    const size_t hstep = TILED ? (size_t)(HALF * BK * 2) : (size_t)HALF * K * 2;
    const size_t tstep = TILED ? (size_t)(K / BK) * (BM * BK * 2) : 2 * hstep;
    const unsigned ldsw = (unsigned)wid * 1024u;
    const int aoff = lds_byte(wr * 64 + fr, fq * 8), boff = lds_byte(wc * 32 + fr, fq * 8);
#define PG8_SA(b, h) (((b) * 2 + (h)) * HTB)
#define PG8_SB(b, h) ((4 + (b) * 2 + (h)) * HTB)
#define PG8_STAGE(bufoff, gbase, voff) do { _Pragma("unroll") for (int _i = 0; _i < 2; ++_i) \
        __builtin_amdgcn_global_load_lds((const unsigned*)((const char*)(gbase) + (voff)[_i]), (LAS unsigned*)(lds + (bufoff) + ldsw + _i * 8192), 16, 0, 0); } while (0)
#define PG8_LDA(dst, b, h) do { _Pragma("unroll") for (int m = 0; m < 4; ++m) _Pragma("unroll") for (int k = 0; k < 2; ++k) dst[m][k] = *(const LAS bf16x8*)(lds + PG8_SA(b, h) + aoff + m * 2048 + k * 1024); } while (0)
#define PG8_LDB(dst, b, h) do { _Pragma("unroll") for (int n = 0; n < 2; ++n) _Pragma("unroll") for (int k = 0; k < 2; ++k) dst[n][k] = *(const LAS bf16x8*)(lds + PG8_SB(b, h) + boff + n * 2048 + k * 1024); } while (0)
#define PG8_MMA(ai, bj, At, Bt) do { __builtin_amdgcn_s_setprio(1); _Pragma("unroll") for (int m = 0; m < 4; ++m) _Pragma("unroll") for (int n = 0; n < 2; ++n) _Pragma("unroll") for (int k = 0; k < 2; ++k) \
        acc[ai][bj][m][n] = __builtin_amdgcn_mfma_f32_16x16x32_bf16(Bt[n][k], At[m][k], acc[ai][bj][m][n], 0, 0, 0); __builtin_amdgcn_s_setprio(0); } while (0)
#define PG8_WAIT_V(n) asm volatile("s_waitcnt vmcnt(" #n ")" ::: "memory")
#define PG8_WAIT_L(n) asm volatile("s_waitcnt lgkmcnt(" #n ")" ::: "memory")
#define PG8_BAR __builtin_amdgcn_s_barrier()
#define PG8_SCHED __builtin_amdgcn_sched_barrier(0)
    Unit cur, nxt; int ui = 0;
    if (!S.next(0, cur)) return;
    f32x4 acc[2][2][4][2];
#pragma unroll
    for (int a = 0; a < 2; ++a)
#pragma unroll
        for (int b = 0; b < 2; ++b)
#pragma unroll
            for (int m = 0; m < 4; ++m)
#pragma unroll
                for (int n = 0; n < 2; ++n) acc[a][b][m][n] = (f32x4){0.f, 0.f, 0.f, 0.f};
    bf16x8 At[4][2], B0[2][2], B1[2][2];
    const char* cA = (const char*)g.A + (size_t)cur.pm * tstep + (size_t)cur.kt0 * kstep; const char* cB = (const char*)g.Bt + (size_t)cur.pn * tstep + (size_t)cur.kt0 * kstep;
    E.prefetch(lds, cur, 0, wid, lane);
    PG8_STAGE(PG8_SB(0, 0), cB, voffB); PG8_STAGE(PG8_SA(0, 0), cA, voffA); PG8_STAGE(PG8_SB(0, 1), cB + hstep, voffB); PG8_STAGE(PG8_SA(0, 1), cA + hstep, voffA);
    if (wr == 1) PG8_BAR;
    PG8_WAIT_V(4); PG8_BAR;
    PG8_STAGE(PG8_SB(1, 0), cB + kstep, voffB); PG8_STAGE(PG8_SA(1, 0), cA + kstep, voffA); PG8_STAGE(PG8_SB(1, 1), cB + hstep + kstep, voffB);
    PG8_WAIT_V(6); PG8_BAR;
    for (;;) {
        const bool has_next = S.next(ui + 1, nxt);
        const char* nA = has_next ? (const char*)g.A + (size_t)nxt.pm * tstep + (size_t)nxt.kt0 * kstep : cA; const char* nB = has_next ? (const char*)g.Bt + (size_t)nxt.pn * tstep + (size_t)nxt.kt0 * kstep : cB;
        const int nt = cur.nkt;
        for (int t = 0; t < nt; t += 2) {
            const bool last = (t == nt - 2);
            const char* a1 = cA + (size_t)(t + 1) * kstep;
            const char* a2 = last ? nA : cA + (size_t)(t + 2) * kstep; const char* b2 = last ? nB : cB + (size_t)(t + 2) * kstep;
            const char* a3 = a2 + kstep; const char* b3 = b2 + kstep;
            PG8_LDB(B0, 0, 0); PG8_SCHED; PG8_LDA(At, 0, 0); PG8_STAGE(PG8_SA(1, 1), a1 + hstep, voffA);
            PG8_WAIT_L(8); PG8_BAR; PG8_WAIT_L(0); PG8_MMA(0, 0, At, B0); PG8_BAR; PG8_SCHED;
            PG8_LDB(B1, 0, 1); PG8_STAGE(PG8_SB(0, 0), b2, voffB);
            PG8_BAR; PG8_WAIT_L(0); PG8_MMA(0, 1, At, B1); PG8_BAR;
            PG8_LDA(At, 0, 1); PG8_STAGE(PG8_SA(0, 0), a2, voffA);
            PG8_BAR; PG8_WAIT_L(0); PG8_MMA(1, 0, At, B0); PG8_BAR; PG8_SCHED;
            PG8_STAGE(PG8_SB(0, 1), b2 + hstep, voffB);
            PG8_WAIT_V(6); PG8_BAR; PG8_MMA(1, 1, At, B1); PG8_BAR;
            PG8_LDB(B0, 1, 0); PG8_SCHED; PG8_LDA(At, 1, 0); PG8_STAGE(PG8_SA(0, 1), a2 + hstep, voffA);
            PG8_WAIT_L(8); PG8_BAR; PG8_WAIT_L(0); PG8_MMA(0, 0, At, B0); PG8_BAR; PG8_SCHED;
            PG8_LDB(B1, 1, 1); PG8_STAGE(PG8_SB(1, 0), b3, voffB);
            PG8_BAR; PG8_WAIT_L(0); PG8_MMA(0, 1, At, B1); PG8_BAR;
            PG8_LDA(At, 1, 1); PG8_STAGE(PG8_SA(1, 0), a3, voffA);
            PG8_BAR; PG8_WAIT_L(0); PG8_MMA(1, 0, At, B0); PG8_BAR; PG8_SCHED;
            PG8_STAGE(PG8_SB(1, 1), b3 + hstep, voffB);
            PG8_WAIT_V(6); PG8_BAR; PG8_MMA(1, 1, At, B1); PG8_BAR;
        }
        if (wr == 0) PG8_BAR;
        asm volatile("" ::: "memory");
        E(acc, cur, wr, wc, fr, fq, lds, ui, has_next, nxt);
        if (!has_next) break;
#pragma unroll
        for (int a = 0; a < 2; ++a)
#pragma unroll
            for (int b = 0; b < 2; ++b)
#pragma unroll
                for (int m = 0; m < 4; ++m)
#pragma unroll
                    for (int n = 0; n < 2; ++n) acc[a][b][m][n] = (f32x4){0.f, 0.f, 0.f, 0.f};
        cur = nxt; cA = nA; cB = nB; ++ui;
        asm volatile("" ::: "memory");
        if (wr == 1) PG8_BAR;
    }
    PG8_WAIT_V(0);
    PG8_BAR;
#undef PG8_SA
#undef PG8_SB
#undef PG8_STAGE
#undef PG8_LDA
#undef PG8_LDB
#undef PG8_MMA
#undef PG8_WAIT_V
#undef PG8_WAIT_L
#undef PG8_BAR
#undef PG8_SCHED
}

#define LDS_WAIT() asm volatile("s_waitcnt lgkmcnt(0)" ::: "memory")
template <int MODE>
__device__ __forceinline__ void p0_transpose_item(const float* W, int K, int N, const float* gain, bf16_t* WT, LAS float* scr, int item, int lane) {
    const int nblk = N / 32, kb = item / nblk, nb = item % nblk, k0 = 64 * kb, n0 = 32 * nb;
    { f32x4 t4[8];
#pragma unroll
      for (int i = 0; i < 8; ++i) { const int kk = 8 * i + (lane >> 3); t4[i] = __builtin_nontemporal_load((const f32x4*)(W + (size_t)(k0 + kk) * N + n0 + (lane & 7) * 4)); if (gain) t4[i] = t4[i] * gain[k0 + kk]; }
#pragma unroll
      for (int i = 0; i < 8; ++i) { const int kk = 8 * i + (lane >> 3); LAS float* d = scr + kk * 33 + (lane & 7) * 4; d[0] = t4[i][0]; d[1] = t4[i][1]; d[2] = t4[i][2]; d[3] = t4[i][3]; } }
    LDS_WAIT(); asm volatile("" ::: "memory");
    const int c = lane & 7;
#pragma unroll
    for (int j = 0; j < 4; ++j) { const int n = (lane >> 3) + 8 * j; const LAS float* s = scr + (8 * c) * 33 + n;
        u32x4 o; o.x = cvt_pk_bf16(s[0 * 33], s[1 * 33]); o.y = cvt_pk_bf16(s[2 * 33], s[3 * 33]); o.z = cvt_pk_bf16(s[4 * 33], s[5 * 33]); o.w = cvt_pk_bf16(s[6 * 33], s[7 * 33]);
        int row = n0 + n;
        if (MODE == 2) { const int half = row >= FF ? 1 : 0, f = row - half * FF; row = (f >> 7) * 256 + half * 128 + (f & 127); }
        if (MODE == 4 && row >= 1024) { const int half = row >= 1536 ? 1 : 0, f = row - 1024 - half * 512; row = 1024 + (f >> 7) * 256 + half * 128 + (f & 127); }
        if (MODE == 3) *(u32x4*)(WT + ((((size_t)(row >> 8) * (K / BK) + (k0 >> 6)) * BM + (row & 255)) * BK + 8 * c)) = o;
        else *(u32x4*)(WT + (size_t)row * K + k0 + 8 * c) = o; }
    LDS_WAIT(); asm volatile("" ::: "memory");
}

template <int PART>
__device__ __forceinline__ void prep_items(const Params& p, LAS unsigned char* lds, int wave, int lane, int gw, int NGW) {
    bf16_t* Wt_in = (bf16_t*)(p.ws + WS_WIN); bf16_t* Wt_out = (bf16_t*)(p.ws + WS_WOUT); bf16_t* Wt_up = (bf16_t*)(p.ws + WS_WUP); bf16_t* Wt_dn = (bf16_t*)(p.ws + WS_WDN);
    bf16_t* hb = (bf16_t*)(p.ws + WS_HB);
    LAS float* scr = (LAS float*)(lds + wave * 16384);
    constexpr int I_FOLD = 1024, I_IN = 16 * 64, I_OUT = 8 * 32, I_UP = 16 * 176, I_DN = 44 * 32, I_ROWS = NTOK / 2;
    constexpr int NITEMS = PART == 0 ? I_IN + I_ROWS : PART == 1 ? I_FOLD + I_OUT : PART == 2 ? I_UP : I_DN;
    for (int it = gw; it < NITEMS; it += NGW) {
        int r = it;
        if (PART == 1) {
            if (r < I_FOLD) {
                const int cblk = r >> 4, n = (r & 15) * 64 + lane, g = cblk >> 4, c0 = (cblk & 15) * 8;
                float a8[8];
#pragma unroll
                for (int e = 0; e < 8; ++e) a8[e] = 0.f;
                const float* wg = p.w_grp + (size_t)(g * 128 + c0) * 128;
#pragma unroll 1
                for (int d0 = 0; d0 < 128; d0 += 16) {
                    float av[16];
#pragma unroll
                    for (int j = 0; j < 16; ++j) av[j] = p.w_out[(size_t)(g * 128 + d0 + j) * DM + n] * p.pool_scale[g * 128 + d0 + j];
#pragma unroll
                    for (int j = 0; j < 16; ++j)
#pragma unroll
                        for (int e = 0; e < 8; ++e) a8[e] = fmaf(wg[e * 128 + d0 + j], av[j], a8[e]);
                }
                *(u32x4*)(Wt_out + (size_t)n * DM + g * 128 + c0) = pack8(a8);
                continue;
            }
            r -= I_FOLD;
            p0_transpose_item<0>(p.w_out + (size_t)512 * DM, DM, DM, nullptr, Wt_out + 512, scr, r, lane);
            continue;
        }
        if (PART == 2) { p0_transpose_item<2>(p.w_up, DM, FF2, p.g2, Wt_up, scr, r, lane); continue; }
        if (PART == 3) { p0_transpose_item<3>(p.w_down, FF, DM, nullptr, Wt_dn, scr, r, lane); continue; }
        if (r < I_IN) { p0_transpose_item<4>(p.w_in, DM, INW, p.g1, Wt_in, scr, r, lane); continue; } r -= I_IN;
        {
            f32x4 v[2][4]; float s[2];
#pragma unroll
            for (int q = 0; q < 2; ++q) { const int row = 2 * r + q; const float* xr = row < NPR ? p.x_prompt + (size_t)row * DM : p.x_sample + (size_t)(row - NPR) * DM;
#pragma unroll
                for (int j = 0; j < 4; ++j) v[q][j] = __builtin_nontemporal_load((const f32x4*)xr + lane + 64 * j); }
#pragma unroll
            for (int q = 0; q < 2; ++q) { s[q] = 0.f;
#pragma unroll
                for (int j = 0; j < 4; ++j) s[q] += (v[q][j][0] * v[q][j][0] + v[q][j][1] * v[q][j][1]) + (v[q][j][2] * v[q][j][2] + v[q][j][3] * v[q][j][3]); }
#pragma unroll
            for (int q = 0; q < 2; ++q) { const float ms = wave_sum(s[q]) * (1.0f / DM) + EPS; const float rstd = rsqrtf(ms);
                if (lane == 0) ((float*)(p.ws + WS_RINV))[2 * r + q] = ms * rstd;
                u32x2* o = (u32x2*)(hb + (size_t)(2 * r + q) * DM) + lane;
#pragma unroll
                for (int j = 0; j < 4; ++j) { u32x2 w; w.x = cvt_pk_bf16(v[q][j][0] * rstd, v[q][j][1] * rstd); w.y = cvt_pk_bf16(v[q][j][2] * rstd, v[q][j][3] * rstd); o[64 * j] = w; } }
        }
    }
}
__device__ __forceinline__ void phase0(const Params& p, LAS unsigned char* lds, int wv) {
    const int tid = opaque_tid(wv), lane = tid & 63;
    const int G = gridDim.x;
    float* ss = (float*)(p.ws + WS_SS);
    for (int i = blockIdx.x * 512 + tid; i < 2 * NTOK; i += G * 512) ss[i] = 0.f;
    { unsigned* cz = (unsigned*)(p.ws + WS_CNT); for (int i = blockIdx.x * 512 + tid; i < 64 * 64; i += G * 512) cz[i] = 0u; }
    prep_items<0>(p, lds, wv, lane, blockIdx.x * 8 + wv, G * 8);
}
template <int PART>
__device__ __forceinline__ void prep_in_idle(const Params& p, LAS unsigned char* lds, int wv, const StaticOrder& S) {
    const int nbusy = S.nwg % S.G;
    if (nbusy == 0) { prep_items<PART>(p, lds, wv, opaque_tid(wv) & 63, blockIdx.x * 8 + wv, S.G * 8); return; }
    if ((int)blockIdx.x < nbusy) return;
    prep_items<PART>(p, lds, wv, opaque_tid(wv) & 63, ((int)blockIdx.x - nbusy) * 8 + wv, (S.G - nbusy) * 8);
}

__device__ __forceinline__ void ld8(const bf16_t* p, float (&f)[8]) { unpack8(__builtin_nontemporal_load((const u32x4*)p), f); }
__device__ __forceinline__ void ld8f(const float* p, float (&f)[8]) { const f32x4 a = *(const f32x4*)p, b = *(const f32x4*)(p + 4); f[0] = a[0]; f[1] = a[1]; f[2] = a[2]; f[3] = a[3]; f[4] = b[0]; f[5] = b[1]; f[6] = b[2]; f[7] = b[3]; }
__device__ __forceinline__ void st8f(float* p, const float (&f)[8]) { *(f32x4*)p = (f32x4){f[0], f[1], f[2], f[3]}; *(f32x4*)(p + 4) = (f32x4){f[4], f[5], f[6], f[7]}; }

__device__ __forceinline__ void p2_prompt_item(const Params& p, const bf16_t* zb, bf16_t* A2, int chunk_, int v) {
    const int chunk = __builtin_amdgcn_readfirstlane(chunk_);
    const int seq = chunk >> 7, t0 = (chunk & 127) * 16;
    const size_t r0 = (size_t)seq * SEQL + t0;
    if (v < 64) {
        const int c = v * 8, g = v >> 4, win = 2 << g;
        const bf16_t* base = zb + r0 * ZP + c;
        bf16_t* ob = A2 + r0 * DM + c;
        float S[8];
#pragma unroll
        for (int e = 0; e < 8; ++e) S[e] = 0.f;
        {
            u32x4 w[15];
#pragma unroll
            for (int k = 1; k < 16; ++k) { w[k - 1] = (u32x4){0u, 0u, 0u, 0u}; if (k < win && t0 > 0) w[k - 1] = *(const u32x4*)(base - (ptrdiff_t)k * ZP); }
#pragma unroll
            for (int k = 0; k < 15; ++k) { float f[8]; unpack8(w[k], f);
#pragma unroll
                for (int e = 0; e < 8; ++e) S[e] += f[e]; }
        }
#pragma unroll
        for (int h = 0; h < 2; ++h) {
            u32x4 cw_[8], ow[8];
#pragma unroll
            for (int i = 0; i < 8; ++i) { const int ri = 8 * h + i, t = t0 + ri;
                cw_[i] = __builtin_nontemporal_load((const u32x4*)(base + (ptrdiff_t)ri * ZP));
                ow[i] = (u32x4){0u, 0u, 0u, 0u}; if (ri >= 1 && t - win >= 0) ow[i] = *(const u32x4*)(base + (ptrdiff_t)(ri - win) * ZP); }
#pragma unroll
            for (int i = 0; i < 8; ++i) { const int ri = 8 * h + i, t = t0 + ri;
                float cur[8], old[8], d[8]; unpack8(cw_[i], cur); unpack8(ow[i], old);
                const float inv = 1.0f / (float)min(t + 1, win);
#pragma unroll
                for (int e = 0; e < 8; ++e) { S[e] += cur[e] - old[e]; d[e] = S[e] * inv - cur[e]; }
                *(u32x4*)(ob + (size_t)ri * DM) = pack8(d);
                if (t >= SEQL - 15) st8f(p.out + O_NPP + ((size_t)seq * 15 + (t - (SEQL - 15))) * 512 + c, cur); }
        }
    } else {
        const int c = (v - 64) * 8;
        const bf16_t* base = zb + r0 * ZP + c;
        bf16_t* ob = A2 + r0 * DM + 512 + c;
        float vm2[8], vm1[8], w0[8], w1[8], w2[8];
        ld8f(p.conv_w + c, w0); ld8f(p.conv_w + 512 + c, w1); ld8f(p.conv_w + 1024 + c, w2);
        if (t0 > 0) { ld8(base - 2 * ZP + 1024, vm2); ld8(base - ZP + 1024, vm1); }
        else {
#pragma unroll
            for (int e = 0; e < 8; ++e) { vm2[e] = 0.f; vm1[e] = 0.f; } }
#pragma unroll
        for (int h = 0; h < 2; ++h) {
            u32x4 gbw[8], vw[8];
#pragma unroll
            for (int i = 0; i < 8; ++i) { const bf16_t* zr = base + (size_t)(8 * h + i) * ZP; gbw[i] = __builtin_nontemporal_load((const u32x4*)(zr + 512)); vw[i] = __builtin_nontemporal_load((const u32x4*)(zr + 1024)); }
#pragma unroll
            for (int i = 0; i < 8; ++i) { const int ri = 8 * h + i, t = t0 + ri;
                float gb[8], vc[8], y[8]; unpack8(gbw[i], gb); unpack8(vw[i], vc);
#pragma unroll
                for (int e = 0; e < 8; ++e) { y[e] = gb[e] * (w0[e] * vm2[e] + w1[e] * vm1[e] + w2[e] * vc[e]); vm2[e] = vm1[e]; vm1[e] = vc[e]; }
                *(u32x4*)(ob + (size_t)ri * DM) = pack8(y);
                if (t >= SEQL - 2) st8f(p.out + O_NCP + ((size_t)seq * 2 + (t - (SEQL - 2))) * 512 + c, vc); }
        }
    }
}
__device__ __forceinline__ void p2_sample_item(const Params& p, const bf16_t* zb, bf16_t* A2, int rr, int v) {
    const int bq = rr >> 3, t = rr & 7; const size_t r = (size_t)NPR + rr;
    if (v < 64) {
        const int c = v * 8, g = v >> 4, win = 2 << g;
        const bf16_t* base = zb + r * ZP + c;
        float sum[8], cur[8];
        u32x4 w[8];
#pragma unroll
        for (int k = 0; k < 8; ++k) { w[k] = (u32x4){0u, 0u, 0u, 0u}; if (k < win && k <= t) w[k] = *(const u32x4*)(base - (ptrdiff_t)k * ZP); }
        unpack8(w[0], cur);
#pragma unroll
        for (int e = 0; e < 8; ++e) sum[e] = cur[e];
#pragma unroll
        for (int k = 1; k < 8; ++k) { float f[8]; unpack8(w[k], f);
#pragma unroll
            for (int e = 0; e < 8; ++e) sum[e] += f[e]; }
        const float* hb_ = p.st_pool + (size_t)bq * 15 * 512 + c;
#pragma unroll
        for (int hh = 0; hh < 3; ++hh) {
            f32x4 ha[5], hb2[5];
#pragma unroll
            for (int q = 0; q < 5; ++q) { const int j = hh * 5 + q; ha[q] = (f32x4){0.f, 0.f, 0.f, 0.f}; hb2[q] = ha[q];
                if (j >= 16 + t - win) { ha[q] = *(const f32x4*)(hb_ + (size_t)j * 512); hb2[q] = *(const f32x4*)(hb_ + (size_t)j * 512 + 4); } }
#pragma unroll
            for (int q = 0; q < 5; ++q) {
#pragma unroll
                for (int e = 0; e < 4; ++e) { sum[e] += ha[q][e]; sum[4 + e] += hb2[q][e]; } }
        }
        const float inv = 1.0f / (float)win;
        float d[8], tmp[8];
#pragma unroll
        for (int e = 0; e < 8; ++e) d[e] = sum[e] * inv - cur[e];
        *(u32x4*)(A2 + r * DM + c) = pack8(d);
        st8f(p.out + O_NPS + ((size_t)bq * 15 + 7 + t) * 512 + c, cur);
        if (t < 7) { ld8f(p.st_pool + ((size_t)bq * 15 + 8 + t) * 512 + c, tmp); st8f(p.out + O_NPS + ((size_t)bq * 15 + t) * 512 + c, tmp); }
    } else {
        const int c = (v - 64) * 8;
        float gb[8], v0[8], v1[8], v2[8], w0[8], w1[8], w2[8];
        const bf16_t* zr = zb + r * ZP + c;
        ld8(zr + 512, gb); ld8(zr + 1024, v2);
        if (t >= 1) ld8(zr - ZP + 1024, v1);
        else ld8f(p.st_conv + ((size_t)bq * 2 + 1) * 512 + c, v1);
        if (t >= 2) ld8(zr - 2 * ZP + 1024, v0);
        else ld8f(p.st_conv + ((size_t)bq * 2 + t) * 512 + c, v0);
        ld8f(p.conv_w + c, w0); ld8f(p.conv_w + 512 + c, w1); ld8f(p.conv_w + 1024 + c, w2);
        float y[8];
#pragma unroll
        for (int e = 0; e < 8; ++e) y[e] = gb[e] * (w0[e] * v0[e] + w1[e] * v1[e] + w2[e] * v2[e]);
        *(u32x4*)(A2 + r * DM + 512 + c) = pack8(y);
        if (t >= 6) st8f(p.out + O_NCS + ((size_t)bq * 2 + (t - 6)) * 512 + c, v2);
    }
}
__device__ __forceinline__ void phase2(const Params& p, int wv) {
    const bf16_t* zb = (const bf16_t*)(p.ws + WS_ZB); bf16_t* A2 = (bf16_t*)(p.ws + WS_A2);
    const int tid0 = blockIdx.x * 512 + opaque_tid(wv);
    for (int it = tid0; it < 1024 * 128; it += gridDim.x * 512) p2_prompt_item(p, zb, A2, it >> 7, it & 127);
    for (int it = tid0; it < 1024 * 128; it += gridDim.x * 512) p2_sample_item(p, zb, A2, it >> 7, it & 127);
}

__device__ __forceinline__ void fixup_rows(const Params& p, int pm, int tid) {
    if (tid >= FF / 8) return;
    const int f0 = tid * 8;
    const float* edge = (const float*)(p.ws + WS_EDGE) + (size_t)(pm - 1) * 2 * FF2 + f0;
    const float* first = (const float*)(p.ws + WS_FIRST) + (size_t)pm * 2 * FF2 + f0;
    bf16_t* actb = (bf16_t*)(p.ws + WS_ACT) + (((size_t)pm * (FF / BK) + (f0 >> 6)) * BM) * BK + (f0 & 63);
    float act0[8], act1[8];
    float ca0[8], ca1[8];
#pragma unroll
    for (int h = 0; h < 2; ++h) {
        float e0[8], e1[8], x0[8], x1[8], w0[8], w1[8], w2[8];
        ld8f(edge + h * FF, e0); ld8f(edge + FF2 + h * FF, e1); ld8f(first + h * FF, x0); ld8f(first + FF2 + h * FF, x1);
        ld8f(p.ffn_cw + h * FF + f0, w0); ld8f(p.ffn_cw + FF2 + h * FF + f0, w1); ld8f(p.ffn_cw + 2 * FF2 + h * FF + f0, w2);
#pragma unroll
        for (int e = 0; e < 8; ++e) {
            const float c0 = w0[e] * e0[e] + w1[e] * e1[e] + w2[e] * x0[e];
            const float c1 = w0[e] * e1[e] + w1[e] * x0[e] + w2[e] * x1[e];
            if (h == 0) { ca0[e] = c0; ca1[e] = c1; }
            else {
                act0[e] = ca0[e] * __builtin_amdgcn_rcpf(1.0f + __builtin_amdgcn_exp2f(ca0[e] * -1.44269504f)) * c0;
                act1[e] = ca1[e] * __builtin_amdgcn_rcpf(1.0f + __builtin_amdgcn_exp2f(ca1[e] * -1.44269504f)) * c1;
            }
        }
    }
    *(u32x4*)(actb) = pack8(act0); *(u32x4*)(actb + BK) = pack8(act1);
}

__device__ __forceinline__ void phase6(const Params& p, int wv) {
    const int lane = opaque_tid(wv) & 63;
    const bool split = (P5_SPLIT && gridDim.x == 256);
    const int gw = blockIdx.x * 8 + wv, NGW = gridDim.x * 8;
    const bf16_t* x2b = (const bf16_t*)(p.ws + WS_X2B); const bf16_t* x1b = (const bf16_t*)(p.ws + WS_X1B);
    const float* part = (const float*)(p.ws + WS_PART);
    float g[16];
    ld8f(p.gf + 8 * lane, *(float (*)[8])&g[0]); ld8f(p.gf + 512 + 8 * lane, *(float (*)[8])&g[8]);
    for (int r2 = (split ? NPR / 2 : 0) + gw; r2 < NTOK / 2; r2 += NGW) {
        u32x4 w[2][2];
        const bool slices = split && 2 * r2 >= NPR;
        const bf16_t* srcb = slices ? x1b : x2b;
#pragma unroll
        for (int q = 0; q < 2; ++q) { w[q][0] = *(const u32x4*)(srcb + (size_t)(2 * r2 + q) * DM + 8 * lane); w[q][1] = *(const u32x4*)(srcb + (size_t)(2 * r2 + q) * DM + 512 + 8 * lane); }
        float v[2][16];
#pragma unroll
        for (int q = 0; q < 2; ++q) { unpack8(w[q][0], *(float (*)[8])&v[q][0]); unpack8(w[q][1], *(float (*)[8])&v[q][8]); }
        if (slices) {
#pragma unroll 2
            for (int ks = 0; ks < 8; ++ks)
#pragma unroll
                for (int q = 0; q < 2; ++q) { const float* pr = part + ((size_t)ks * 1024 + (2 * r2 + q - NPR)) * DM + 8 * lane;
                    float t[16]; ld8f(pr, *(float (*)[8])&t[0]); ld8f(pr + 512, *(float (*)[8])&t[8]);
#pragma unroll
                    for (int e = 0; e < 16; ++e) v[q][e] += t[e]; }
        }
#pragma unroll
        for (int q = 0; q < 2; ++q) { float s = 0.f;
#pragma unroll
            for (int e = 0; e < 16; ++e) s += v[q][e] * v[q][e];
            const float rstd = rsqrtf(wave_sum(s) * (1.0f / DM) + EPS);
            float o[16];
#pragma unroll
            for (int e = 0; e < 16; ++e) o[e] = v[q][e] * rstd * g[e];
            float* dst = p.out + (size_t)(2 * r2 + q) * DM + 8 * lane;
            st8f(dst, *(const float (*)[8])&o[0]); st8f(dst + 512, *(const float (*)[8])&o[8]); }
    }
}

template <int PH>
__device__ __forceinline__ void run_phase(const Params& p, LAS unsigned char* lds, int wv) {
    StaticOrder S;
    if (PH == 0) phase0(p, lds, wv);
    if (PH == 1) { Gemm g{(const bf16_t*)(p.ws + WS_HB), (const bf16_t*)(p.ws + WS_WIN), NTOK, INW, DM}; S.init(NTOK, INW, DM, gridDim.x, blockIdx.x, 0);
        EpiZ E{(bf16_t*)(p.ws + WS_ZB), ZP}; gemm_phase(lds, g, S, E, wv);
        prep_in_idle<1>(p, lds, wv, S); prep_in_idle<2>(p, lds, wv, S); }
    if (PH == 2) phase2(p, wv);
    if (PH == 3) { Gemm g{(const bf16_t*)(p.ws + WS_A2), (const bf16_t*)(p.ws + WS_WOUT), NTOK, DM, DM}; S.init(NPR, DM, DM, gridDim.x, blockIdx.x, 0);
        EpiRes<false> E{(const float*)(p.ws + WS_RINV), (const bf16_t*)(p.ws + WS_HB), (bf16_t*)(p.ws + WS_X1B), (float*)(p.ws + WS_SS), DM / BK, nullptr}; gemm_phase(lds, g, S, E, wv); }
    if (PH == 4) {
        const int G = gridDim.x, c = blockIdx.x;
        unsigned* ready = (unsigned*)(p.ws + WS_BAR);
        if (c >= G - 16) {
            const int j = c - (G - 16);
            Gemm g3{(const bf16_t*)(p.ws + WS_A2), (const bf16_t*)(p.ws + WS_WOUT), NTOK, DM, DM}; StaticOrder S1; S1.init(NTOK, DM, DM, G, c, 2); S1.spm = 64 + (j >> 2); S1.spn = j & 3;
            EpiRes<false> E3{(const float*)(p.ws + WS_RINV), (const bf16_t*)(p.ws + WS_HB), (bf16_t*)(p.ws + WS_X1B), (float*)(p.ws + WS_SS), DM / BK, nullptr}; gemm_phase(lds, g3, S1, E3, wv);
            __threadfence(); __syncthreads();
            if (opaque_tid(wv) == 0) __hip_atomic_fetch_add(ready, 1u, __ATOMIC_RELAXED, __HIP_MEMORY_SCOPE_AGENT);
        }
        Gemm g{(const bf16_t*)(p.ws + WS_X1B), (const bf16_t*)(p.ws + WS_WUP), NTOK, FF2, DM}; S.init(NPR, FF2, DM, G, c, 0);
        EpiUp E{(const float*)(p.ws + WS_SS), p.ffn_cw, p.st_ffn, (bf16_t*)(p.ws + WS_ACT), (float*)(p.ws + WS_EDGE), (float*)(p.ws + WS_FIRST), p.out + O_NFP, p.out + O_NFS}; gemm_phase(lds, g, S, E, wv);
        const int nfull = S.nwg % G;
        if (c >= nfull && c < nfull + 88 && c < G - 16) {
            if (wv == 0) {
                unsigned polls = 0;
                while ((unsigned)__builtin_amdgcn_readfirstlane(__hip_atomic_load(ready, __ATOMIC_RELAXED, __HIP_MEMORY_SCOPE_AGENT)) < 16u) { __builtin_amdgcn_s_sleep(4); if (++polls > (1u << 17)) break; }
                __builtin_amdgcn_fence(__ATOMIC_ACQUIRE, "agent");
                asm volatile("s_waitcnt vmcnt(0)" ::: "memory");
            }
            __syncthreads();
            const int idx = c - nfull;
            StaticOrder S2; S2.init(NTOK, FF2, DM, G, c, 2); S2.spm = 64 + idx / 22; S2.spn = idx % 22;
            gemm_phase(lds, g, S2, E, wv);
        } else if (c >= nfull + 88 && c < G - 16) {
            prep_items<3>(p, lds, wv, opaque_tid(wv) & 63, (c - nfull - 88) * 8 + wv, (G - 16 - nfull - 88) * 8);
        }
    }
    if (PH == 5) { Gemm g{(const bf16_t*)(p.ws + WS_ACT), (const bf16_t*)(p.ws + WS_WDN), NTOK, DM, FF};
        S.init(NTOK, DM, FF, gridDim.x, blockIdx.x, (P5_SPLIT && gridDim.x == 256) ? 1 : 0);
        { Unit u; for (int i = 0; S.next(i, u); ++i) if (u.pm < 64 && (u.pm & 7) != 0) fixup_rows(p, u.pm, opaque_tid(wv)); }
        asm volatile("s_waitcnt vmcnt(0)" ::: "memory"); __syncthreads();
        if (S.split == 1) { EpiDownFused E{(const bf16_t*)(p.ws + WS_X1B), p.out, p.gf, (float*)(p.ws + WS_SS) + NTOK, (unsigned*)(p.ws + WS_CNT), FF / BK, (float*)(p.ws + WS_PART)}; gemm_phase<EpiDownFused, true>(lds, g, S, E, wv); }
        else { EpiRes<true> E{nullptr, (const bf16_t*)(p.ws + WS_X1B), (bf16_t*)(p.ws + WS_X2B), nullptr, FF / BK, (float*)(p.ws + WS_PART)}; gemm_phase<EpiRes<true>, true>(lds, g, S, E, wv); } }
    if (PH == 6) phase6(p, wv);
}

extern __shared__ __attribute__((aligned(16))) unsigned char g_shm[];

template <int PH> __global__ __launch_bounds__(512, 2) void k_phase(Params p) { run_phase<PH>(p, (LAS unsigned char*)g_shm, __builtin_amdgcn_readfirstlane(threadIdx.x >> 6)); }

#if !MULTI_LAUNCH
__global__ __launch_bounds__(512, 2) void k_mega(Params p) {
    cg::grid_group grid = cg::this_grid();
    LAS unsigned char* lds = (LAS unsigned char*)g_shm;
    if (p.ws == nullptr) grid.sync();
    const int wv = __builtin_amdgcn_readfirstlane(threadIdx.x >> 6);
    volatile LAS unsigned* st = (volatile LAS unsigned*)(lds + STAGE_BYTES + XCH_BYTES);
    const int tid_ = opaque_tid(wv);
    if (tid_ == 0) { st[0] = 0u; st[1] = 0u; st[2] = 0u; st[3] = 0u; }
    __syncthreads();
    const XcdBarrier xb = xcd_barrier_post((unsigned*)(p.ws + WS_BAR), st, tid_);
    run_phase<0>(p, lds, wv); xcd_barrier(xb, wv);
    if (DUP_PHASE == 0) { run_phase<0>(p, lds, wv); xcd_barrier(xb, wv); }
    run_phase<1>(p, lds, wv); xcd_barrier(xb, wv);
    if (DUP_PHASE == 1) { run_phase<1>(p, lds, wv); xcd_barrier(xb, wv); }
    run_phase<2>(p, lds, wv); xcd_barrier(xb, wv);
    if (DUP_PHASE == 2) { run_phase<2>(p, lds, wv); xcd_barrier(xb, wv); }
    run_phase<3>(p, lds, wv); xcd_barrier(xb, wv);
    if (DUP_PHASE == 3) { { float* ss = (float*)(p.ws + WS_SS); for (int i = blockIdx.x * 512 + opaque_tid(wv); i < NTOK; i += gridDim.x * 512) ss[i] = 0.f; } xcd_barrier(xb, wv); run_phase<3>(p, lds, wv); xcd_barrier(xb, wv); }
    run_phase<4>(p, lds, wv); xcd_barrier(xb, wv);
    if (DUP_PHASE == 4) { run_phase<4>(p, lds, wv); xcd_barrier(xb, wv); }
    run_phase<5>(p, lds, wv); xcd_barrier(xb, wv);
    if (DUP_PHASE == 5) { run_phase<5>(p, lds, wv); xcd_barrier(xb, wv); }
    run_phase<6>(p, lds, wv);
    if (DUP_PHASE == 6) { xcd_barrier(xb, wv); run_phase<6>(p, lds, wv); }
}
#endif

extern "C" void kernel_launch(void* const* d_in, const int* in_sizes, int n_in, void* d_out, int out_size, void* d_ws, size_t ws_size, hipStream_t stream) {
    static int grid = 0;
    if (grid == 0) {
        int dev = 0, cus = 0, per_cu = 0;
        hipGetDevice(&dev);
        hipDeviceGetAttribute(&cus, hipDeviceAttributeMultiprocessorCount, dev);
#if MULTI_LAUNCH
        hipFuncSetAttribute((const void*)k_phase<0>, hipFuncAttributeMaxDynamicSharedMemorySize, LDS_BYTES);
        hipFuncSetAttribute((const void*)k_phase<1>, hipFuncAttributeMaxDynamicSharedMemorySize, LDS_BYTES);
        hipFuncSetAttribute((const void*)k_phase<2>, hipFuncAttributeMaxDynamicSharedMemorySize, LDS_BYTES);
        hipFuncSetAttribute((const void*)k_phase<3>, hipFuncAttributeMaxDynamicSharedMemorySize, LDS_BYTES);
        hipFuncSetAttribute((const void*)k_phase<4>, hipFuncAttributeMaxDynamicSharedMemorySize, LDS_BYTES);
        hipFuncSetAttribute((const void*)k_phase<5>, hipFuncAttributeMaxDynamicSharedMemorySize, LDS_BYTES);
        hipFuncSetAttribute((const void*)k_phase<6>, hipFuncAttributeMaxDynamicSharedMemorySize, LDS_BYTES);
        per_cu = 1;
#else
        hipFuncSetAttribute((const void*)k_mega, hipFuncAttributeMaxDynamicSharedMemorySize, LDS_BYTES);
        if (hipOccupancyMaxActiveBlocksPerMultiprocessor(&per_cu, (const void*)k_mega, 512, LDS_BYTES) != hipSuccess || per_cu < 1) {
            fprintf(stderr, "kernel_launch: occupancy query says %d blocks per CU\n", per_cu); per_cu = 1; }
        if (per_cu > 1) per_cu = 1;
#endif
        (void)hipGetLastError();
        grid = cus * per_cu;
        if (ws_size < 234 * MiB) fprintf(stderr, "kernel_launch: workspace too small (%zu)\n", ws_size);
    }
    Params p{};
    p.x_prompt = (const float*)d_in[0]; p.x_sample = (const float*)d_in[1]; p.st_pool = (const float*)d_in[2]; p.st_conv = (const float*)d_in[3]; p.st_ffn = (const float*)d_in[4];
    p.g1 = (const float*)d_in[5]; p.w_in = (const float*)d_in[6]; p.w_grp = (const float*)d_in[7]; p.pool_scale = (const float*)d_in[8]; p.conv_w = (const float*)d_in[9];
    p.w_out = (const float*)d_in[10]; p.g2 = (const float*)d_in[11]; p.w_up = (const float*)d_in[12]; p.ffn_cw = (const float*)d_in[13]; p.w_down = (const float*)d_in[14]; p.gf = (const float*)d_in[15];
    p.out = (float*)d_out; p.ws = (unsigned char*)d_ws;
#if MULTI_LAUNCH
    hipLaunchKernelGGL(k_phase<0>, dim3(grid), dim3(512), LDS_BYTES, stream, p);
    hipLaunchKernelGGL(k_phase<1>, dim3(grid), dim3(512), LDS_BYTES, stream, p);
    hipLaunchKernelGGL(k_phase<2>, dim3(grid), dim3(512), LDS_BYTES, stream, p);
    hipLaunchKernelGGL(k_phase<3>, dim3(grid), dim3(512), LDS_BYTES, stream, p);
    hipLaunchKernelGGL(k_phase<4>, dim3(grid), dim3(512), LDS_BYTES, stream, p);
    hipLaunchKernelGGL(k_phase<5>, dim3(grid), dim3(512), LDS_BYTES, stream, p);
    hipLaunchKernelGGL(k_phase<6>, dim3(grid), dim3(512), LDS_BYTES, stream, p);
#else
    (void)hipMemsetAsync((unsigned char*)d_ws + WS_BAR, 0, XCD_BAR_WORDS * 4, stream);
    void* args[] = {&p};
    hipError_t e = hipLaunchCooperativeKernel((const void*)k_mega, dim3(grid), dim3(512), args, LDS_BYTES, stream);
    if (e != hipSuccess) fprintf(stderr, "cooperative launch failed: %s (grid %d)\n", hipGetErrorString(e), grid);
#endif
}
```

```cpp
#include <hip/hip_runtime.h>
#include <hip/hip_cooperative_groups.h>
#include <hip/amd_detail/amd_hip_unsafe_atomics.h>
#include <cstdio>
namespace cg = cooperative_groups;

#ifndef MULTI_LAUNCH
#define MULTI_LAUNCH 0
#endif
#ifndef P5_SPLIT
#define P5_SPLIT 1
#endif
#ifndef DUP_PHASE
#define DUP_PHASE -1
#endif

#define LAS __attribute__((address_space(3)))
typedef unsigned short bf16_t;
typedef short bf16x8 __attribute__((ext_vector_type(8)));
typedef float f32x4 __attribute__((ext_vector_type(4)));
typedef unsigned u32x4 __attribute__((ext_vector_type(4)));
typedef unsigned u32x2 __attribute__((ext_vector_type(2)));

constexpr int NTOK = 17408, NPR = 16384, DM = 1024, INW = 2048, FF = 2816, FF2 = 5632;
constexpr int ZP = 1536;
constexpr int SEQL = 2048;
constexpr float EPS = 1e-6f;

constexpr size_t MiB = 1u << 20;
constexpr size_t WS_WIN = 0, WS_WOUT = 4 * MiB, WS_WUP = 6 * MiB, WS_WDN = 17 * MiB, WS_SS = 23 * MiB, WS_BAR = 23 * MiB + 512 * 1024, WS_RINV = 23 * MiB + 256 * 1024, WS_CNT = 23 * MiB + 160 * 1024, WS_EDGE = 24 * MiB, WS_FIRST = 27 * MiB,
                 WS_HB = 30 * MiB, WS_ZB = 64 * MiB, WS_A2 = 132 * MiB, WS_X1B = 166 * MiB, WS_ACT = 64 * MiB, WS_PART = 200 * MiB, WS_X2B = 200 * MiB;
constexpr size_t O_Y = 0, O_NPP = 17825792, O_NCP = 17887232, O_NFP = 17895424, O_NPS = 17985536, O_NCS = 18968576, O_NFS = 19099648;

struct Params {
    const float *x_prompt, *x_sample, *st_pool, *st_conv, *st_ffn, *g1, *w_in, *w_grp, *pool_scale, *conv_w, *w_out, *g2, *w_up, *ffn_cw, *w_down, *gf;
    float* out; unsigned char* ws;
};

constexpr int BM = 256, BK = 64, HALF = 128, HTB = HALF * BK * 2, STAGE_BYTES = 8 * HTB, NXCD = 8, WGM = 8;
constexpr int XCH_BYTES = 8192, RT_OFF = STAGE_BYTES + XCH_BYTES + 16, TAB_OFF = RT_OFF + 1024, TAB_BYTES = 4096, LDS_BYTES = TAB_OFF + 2 * TAB_BYTES;

__device__ __forceinline__ int lds_byte(int r, int c) { const int st = (r >> 4) * 2 + (c >> 5), rr = r & 15, cc = c & 31, ob = rr * 64 + cc * 2; return st * 1024 + (ob ^ (((ob >> 9) & 1) << 5)); }
__device__ __forceinline__ void stage_rc(int b, int& R, int& C) { const int st = b / 1024, sb = b % 1024, swz = sb ^ (((sb >> 9) & 1) << 5); R = (st >> 1) * 16 + swz / 64; C = (st & 1) * 32 + (swz % 64) / 2; }
__device__ __forceinline__ int perm32(int rho) { const int n = rho >> 4, i = rho & 15; return 8 * (i >> 2) + 4 * n + (i & 3); }

struct Unit { int pm, pn, kt0, nkt; };
struct Gemm { const bf16_t* A; const bf16_t* Bt; int M, N, K; };

struct StaticOrder {
    int nM, nN, nwg, G, c, nkt, split, spm, spn;
    __device__ void init(int M, int N, int K, int G_, int c_, int split_) { nM = M / BM; nN = N / BM; nwg = nM * nN; G = G_; c = c_; nkt = K / BK; split = split_; }
    __device__ void tile(int L, Unit& u) const {
        if (split) { if (L < 256) { u.pm = 8 * (L & 7) + ((L >> 3) & 7); u.pn = L >> 6; } else { u.pm = 64 + ((L - 256) >> 2); u.pn = (L - 256) & 3; } return; }
        int wgid = L; { const int q = nwg / NXCD, r = nwg % NXCD, xcd = wgid % NXCD, off = wgid / NXCD; wgid = (xcd < r ? xcd * (q + 1) : r * (q + 1) + (xcd - r) * q) + off; }
        const int nig = WGM * nN, gid = wgid / nig, fm = gid * WGM, gsz = (nM - fm) < WGM ? (nM - fm) : WGM;
        u.pm = fm + ((wgid % nig) % gsz); u.pn = (wgid % nig) / gsz;
    }
    __device__ bool next(int i, Unit& u) const {
        if (split == 2) { if (i) return false; u.pm = spm; u.pn = spn; u.kt0 = 0; u.nkt = nkt; return true; }
        if (split && i >= 1) {
            const int s = c; if (i > 1 || s >= 8 * (nwg - G)) return false;
            tile(G + (s >> 3), u); const int ks = s & 7; u.kt0 = ks < 6 ? 6 * ks : 36 + 4 * (ks - 6); u.nkt = ks < 6 ? 6 : 4; return true;
        }
        const long L = (long)i * G + c; if (L >= nwg) return false;
        tile((int)L, u); u.kt0 = 0; u.nkt = nkt; return true;
    }
    __device__ int count() const { Unit u; int n = 0; while (next(n, u)) ++n; return n; }
};

__device__ __forceinline__ unsigned cvt_pk_bf16(float lo, float hi) { unsigned r; asm("v_cvt_pk_bf16_f32 %0, %1, %2" : "=v"(r) : "v"(lo), "v"(hi)); return r; }
__device__ __forceinline__ float bf_lo(unsigned w) { return __uint_as_float(w << 16); }
__device__ __forceinline__ float bf_hi(unsigned w) { return __uint_as_float(w & 0xffff0000u); }
__device__ __forceinline__ void unpack8(const u32x4 w, float (&f)[8]) { f[0] = bf_lo(w.x); f[1] = bf_hi(w.x); f[2] = bf_lo(w.y); f[3] = bf_hi(w.y); f[4] = bf_lo(w.z); f[5] = bf_hi(w.z); f[6] = bf_lo(w.w); f[7] = bf_hi(w.w); }
__device__ __forceinline__ u32x4 pack8(const float (&f)[8]) { u32x4 w; w.x = cvt_pk_bf16(f[0], f[1]); w.y = cvt_pk_bf16(f[2], f[3]); w.z = cvt_pk_bf16(f[4], f[5]); w.w = cvt_pk_bf16(f[6], f[7]); return w; }
__device__ __forceinline__ float wave_sum(float v) {
#pragma unroll
    for (int o = 1; o < 64; o <<= 1) v += __shfl_xor(v, o);
    return v;
}
__device__ __forceinline__ int opaque_tid(int wv) { int l; asm volatile("v_mbcnt_lo_u32_b32 %0, -1, 0\n\tv_mbcnt_hi_u32_b32 %0, -1, %0" : "=v"(l)); return wv * 64 + l; }
template <int CTRL> __device__ __forceinline__ float dppf(float v) { return __int_as_float(__builtin_amdgcn_update_dpp(0, __float_as_int(v), CTRL, 0xf, 0xf, true)); }


#define XB_TMO      128
#define XB_XCNT(j)  (256  + 64 * (j))
#define XB_XSUB(j)  (1280 + 64 * (j))
#define XB_XGEN(j)  (2304 + 64 * (j))
#define XB_TOP      3328
#define XB_TOPGEN   3392
#define XCD_BAR_WORDS 3456
#define XB_SPIN_CAP (1u << 18)
__device__ __forceinline__ unsigned xb_ld(unsigned* p)              { return __hip_atomic_load(p, __ATOMIC_RELAXED, __HIP_MEMORY_SCOPE_AGENT); }
__device__ __forceinline__ unsigned xb_add(unsigned* p, unsigned v) { return __hip_atomic_fetch_add(p, v, __ATOMIC_RELAXED, __HIP_MEMORY_SCOPE_AGENT); }
__device__ __forceinline__ unsigned xb_xcc_id() { return (unsigned)__builtin_amdgcn_s_getreg((3 << 11) | 20) & 0xFu; }
#define XB_SPIN(cond, bar) do { unsigned _sp = 0; while (cond) { __builtin_amdgcn_s_sleep(1); \
    if ((++_sp & 255u) == 0u) { if (xb_ld(&(bar)[XB_TMO])) break; if (_sp > XB_SPIN_CAP) { atomicAdd(&(bar)[XB_TMO], 1u); break; } } } } while (0)
struct XcdBarrier { unsigned* bar; unsigned x; volatile LAS unsigned* st; };
__device__ __forceinline__ XcdBarrier xcd_barrier_post(unsigned* bar, volatile LAS unsigned* st, int tid) {
    XcdBarrier b; b.bar = bar; b.x = xb_xcc_id(); b.st = st;
    if (tid == 0) (void)xb_add(&bar[XB_XCNT(b.x)], 1u);
    return b;
}
__device__ __forceinline__ void xcd_barrier_complete(unsigned* bar, unsigned x, unsigned& nloc, unsigned& nx) {
    const unsigned G = gridDim.x * gridDim.y * gridDim.z;
    unsigned sum, cnt, mine, sp = 0u;
    for (;;) {
        sum = 0u; cnt = 0u; mine = 0u;
#pragma unroll
        for (unsigned j = 0; j < 16; ++j) { const unsigned c = xb_ld(&bar[XB_XCNT(j)]); sum += c; cnt += (c > 0u) ? 1u : 0u; mine = (j == x) ? c : mine; }
        if (sum == G) break;
        __builtin_amdgcn_s_sleep(1);
        if ((++sp & 255u) == 0u) { if (xb_ld(&bar[XB_TMO])) break; if (sp > XB_SPIN_CAP) { atomicAdd(&bar[XB_TMO], 1u); break; } }
    }
    nloc = mine > 0u ? mine : 1u; nx = cnt > 0u ? cnt : 1u;
}
__device__ __forceinline__ void xcd_barrier(const XcdBarrier& b, int wv) {
    asm volatile("s_waitcnt vmcnt(0)" ::: "memory");
    __syncthreads();
    if (opaque_tid(wv) == 0) {
        unsigned* bar = b.bar;
        __builtin_amdgcn_s_waitcnt(0);
        unsigned nloc = b.st[0], nx = b.st[1];
        if (nloc == 0u) { xcd_barrier_complete(bar, b.x, nloc, nx); b.st[0] = nloc; b.st[1] = nx; }
        const unsigned old = xb_add(&bar[XB_XSUB(b.x)], 1u);
        const unsigned gen = old / nloc;
        if (old + 1u == (gen + 1u) * nloc) {
            __builtin_amdgcn_fence(__ATOMIC_RELEASE, "agent");
            asm volatile("s_waitcnt vmcnt(0)" ::: "memory");
            const unsigned og = xb_add(&bar[XB_TOP], 1u);
            const unsigned tg = og / nx;
            if (og + 1u == (tg + 1u) * nx) xb_add(&bar[XB_TOPGEN], 1u);
            else XB_SPIN(xb_ld(&bar[XB_TOPGEN]) == tg, bar);
            __builtin_amdgcn_fence(__ATOMIC_ACQUIRE, "agent");
            xb_add(&bar[XB_XGEN(b.x)], 1u);
            asm volatile("s_waitcnt vmcnt(0)" ::: "memory");
        } else {
            XB_SPIN(xb_ld(&bar[XB_XGEN(b.x)]) == gen, bar);
            __builtin_amdgcn_fence(__ATOMIC_ACQUIRE, "agent");
            asm volatile("s_waitcnt vmcnt(0)" ::: "memory");
        }
    }
    __syncthreads();
}

struct EpiZ {
    bf16_t* O; int ldc;
    __device__ __forceinline__ void prefetch(LAS unsigned char*, const Unit&, int, int, int) const {}
    __device__ __forceinline__ void operator()(const f32x4 (&acc)[2][2][4][2], const Unit& u, int wr, int wc, int fr, int fq, LAS unsigned char*, int, bool, const Unit&) const {
        const int row0 = u.pm * BM + wr * 64 + fr, col0 = u.pn * BM + wc * 32 + 8 * fq;
        if (u.pn >= 4) {
            const int colv = 1024 + (u.pn - 4) * 128 + wc * 32 + 8 * fq;
#pragma unroll
            for (int ai = 0; ai < 2; ++ai)
#pragma unroll
                for (int m = 0; m < 4; ++m) { const f32x4 v0 = acc[ai][0][m][0] * acc[ai][1][m][0], v1 = acc[ai][0][m][1] * acc[ai][1][m][1];
                    u32x4 w; w.x = cvt_pk_bf16(v0[0], v0[1]); w.y = cvt_pk_bf16(v0[2], v0[3]); w.z = cvt_pk_bf16(v1[0], v1[1]); w.w = cvt_pk_bf16(v1[2], v1[3]);
                    *(u32x4*)(O + (size_t)(row0 + ai * HALF + m * 16) * ldc + colv) = w; }
            return;
        }
#pragma unroll
        for (int ai = 0; ai < 2; ++ai)
#pragma unroll
            for (int m = 0; m < 4; ++m) { bf16_t* rowp = O + (size_t)(row0 + ai * HALF + m * 16) * ldc + col0;
#pragma unroll
                for (int bj = 0; bj < 2; ++bj) { const f32x4 v0 = acc[ai][bj][m][0], v1 = acc[ai][bj][m][1];
                    u32x4 w; w.x = cvt_pk_bf16(v0[0], v0[1]); w.y = cvt_pk_bf16(v0[2], v0[3]); w.z = cvt_pk_bf16(v1[0], v1[1]); w.w = cvt_pk_bf16(v1[2], v1[3]);
                    *(u32x4*)(rowp + bj * HALF) = w; } }
    }
};
template <bool RES_BF16>
struct EpiRes {
    const float* rscale; const bf16_t* rb; bf16_t* xb; float* ss; int full_nkt; float* part;
    __device__ __forceinline__ void prefetch(LAS unsigned char*, const Unit&, int, int, int) const {}
    __device__ __forceinline__ void operator()(const f32x4 (&acc)[2][2][4][2], const Unit& u, int wr, int wc, int fr, int fq, LAS unsigned char*, int, bool, const Unit&) const {
        const int row0 = u.pm * BM + wr * 64 + fr, col0 = u.pn * BM + wc * 32 + 8 * fq;
        if (u.nkt != full_nkt) {
            const int ks = u.kt0 < 36 ? u.kt0 / 6 : 6 + (u.kt0 - 36) / 4;
#pragma unroll
            for (int ai = 0; ai < 2; ++ai)
#pragma unroll
                for (int m = 0; m < 4; ++m) { float* dst = part + ((size_t)ks * 1024 + (row0 - NPR + ai * HALF + m * 16)) * DM + col0;
#pragma unroll
                    for (int bj = 0; bj < 2; ++bj)
#pragma unroll
                        for (int n = 0; n < 2; ++n) *(f32x4*)(dst + bj * HALF + n * 4) = acc[ai][bj][m][n]; }
            return;
        }
#pragma unroll
        for (int ai = 0; ai < 2; ++ai) {
            f32x4 rr[4][2][2];
#pragma unroll
            for (int m = 0; m < 4; ++m) {
                const float sc = RES_BF16 ? 1.0f : rscale[row0 + ai * HALF + m * 16];
#pragma unroll
                for (int bj = 0; bj < 2; ++bj) {
                    const u32x4 w = *(const u32x4*)(rb + (size_t)(row0 + ai * HALF + m * 16) * DM + col0 + bj * HALF);
                    rr[m][bj][0] = (f32x4){bf_lo(w.x), bf_hi(w.x), bf_lo(w.y), bf_hi(w.y)}; rr[m][bj][1] = (f32x4){bf_lo(w.z), bf_hi(w.z), bf_lo(w.w), bf_hi(w.w)};
                    if (!RES_BF16) { rr[m][bj][0] = rr[m][bj][0] * sc; rr[m][bj][1] = rr[m][bj][1] * sc; } } }
#pragma unroll
            for (int m = 0; m < 4; ++m) {
                const int row = row0 + ai * HALF + m * 16;
                float q = 0.f;
#pragma unroll
                for (int bj = 0; bj < 2; ++bj) {
                    const f32x4 v0 = acc[ai][bj][m][0] + rr[m][bj][0], v1 = acc[ai][bj][m][1] + rr[m][bj][1];
                    u32x4 w; w.x = cvt_pk_bf16(v0[0], v0[1]); w.y = cvt_pk_bf16(v0[2], v0[3]); w.z = cvt_pk_bf16(v1[0], v1[1]); w.w = cvt_pk_bf16(v1[2], v1[3]);
                    *(u32x4*)(xb + (size_t)row * DM + col0 + bj * HALF) = w;
                    q += (v0[0] * v0[0] + v0[1] * v0[1]) + (v0[2] * v0[2] + v0[3] * v0[3]) + (v1[0] * v1[0] + v1[1] * v1[1]) + (v1[2] * v1[2] + v1[3] * v1[3]);
                }
                if (!RES_BF16) { q += __shfl_xor(q, 16); q += __shfl_xor(q, 32); if (fq == 0) atomicAdd(ss + row, q); }
            }
        }
    }
};

struct EpiDownFused {
    const bf16_t* rb; float* yout; const float* gf; float* ss3; unsigned* cnt; int full_nkt; float* part;
    __device__ __forceinline__ void prefetch(LAS unsigned char*, const Unit&, int, int, int) const {}
    __device__ __forceinline__ void operator()(f32x4 (&acc)[2][2][4][2], const Unit& u, int wr, int wc, int fr, int fq, LAS unsigned char*, int, bool, const Unit&) const {
        const int row0 = u.pm * BM + wr * 64 + fr, col0 = u.pn * BM + wc * 32 + 8 * fq;
        if (u.nkt != full_nkt) {
            const int ks = u.kt0 < 36 ? u.kt0 / 6 : 6 + (u.kt0 - 36) / 4;
#pragma unroll
            for (int ai = 0; ai < 2; ++ai)
#pragma unroll
                for (int m = 0; m < 4; ++m) { float* dst = part + ((size_t)ks * 1024 + (row0 - NPR + ai * HALF + m * 16)) * DM + col0;
#pragma unroll
                    for (int bj = 0; bj < 2; ++bj)
#pragma unroll
                        for (int n = 0; n < 2; ++n) *(f32x4*)(dst + bj * HALF + n * 4) = acc[ai][bj][m][n]; }
            return;
        }
#pragma unroll
        for (int ai = 0; ai < 2; ++ai) {
            u32x4 rw[4][2];
#pragma unroll
            for (int m = 0; m < 4; ++m)
#pragma unroll
                for (int bj = 0; bj < 2; ++bj) rw[m][bj] = *(const u32x4*)(rb + (size_t)(row0 + ai * HALF + m * 16) * DM + col0 + bj * HALF);
#pragma unroll
            for (int m = 0; m < 4; ++m) {
                float q = 0.f;
#pragma unroll
                for (int bj = 0; bj < 2; ++bj) { const u32x4 w = rw[m][bj];
                    const f32x4 v0 = acc[ai][bj][m][0] + (f32x4){bf_lo(w.x), bf_hi(w.x), bf_lo(w.y), bf_hi(w.y)}, v1 = acc[ai][bj][m][1] + (f32x4){bf_lo(w.z), bf_hi(w.z), bf_lo(w.w), bf_hi(w.w)};
                    acc[ai][bj][m][0] = v0; acc[ai][bj][m][1] = v1;
                    q += (v0[0] * v0[0] + v0[1] * v0[1]) + (v0[2] * v0[2] + v0[3] * v0[3]) + (v1[0] * v1[0] + v1[1] * v1[1]) + (v1[2] * v1[2] + v1[3] * v1[3]); }
                q += __shfl_xor(q, 16); q += __shfl_xor(q, 32);
                if (fq == 0) atomicAdd(ss3 + row0 + ai * HALF + m * 16, q);
            }
        }
        asm volatile("s_waitcnt vmcnt(0)" ::: "memory"); __builtin_amdgcn_s_barrier(); asm volatile("" ::: "memory");
        if (wr == 0 && wc == 0) {
            unsigned* c4 = cnt + 64 * u.pm;
            if (fr == 0 && fq == 0) __hip_atomic_fetch_add(c4, 1u, __ATOMIC_RELAXED, __HIP_MEMORY_SCOPE_AGENT);
            unsigned polls = 0;
            while ((unsigned)__builtin_amdgcn_readfirstlane(__hip_atomic_load(c4, __ATOMIC_RELAXED, __HIP_MEMORY_SCOPE_AGENT)) < 4u) { __builtin_amdgcn_s_sleep(2); if (++polls > (1u << 17)) break; }
        }
        asm volatile("" ::: "memory"); __builtin_amdgcn_s_barrier(); asm volatile("" ::: "memory");
        f32x4 g[2][2];
#pragma unroll
        for (int bj = 0; bj < 2; ++bj) { g[bj][0] = *(const f32x4*)(gf + col0 + bj * HALF); g[bj][1] = *(const f32x4*)(gf + col0 + bj * HALF + 4); }
#pragma unroll
        for (int ai = 0; ai < 2; ++ai)
#pragma unroll
            for (int m = 0; m < 4; ++m) {
                const int row = row0 + ai * HALF + m * 16;
                const float rstd = rsqrtf(__hip_atomic_load(ss3 + row, __ATOMIC_RELAXED, __HIP_MEMORY_SCOPE_AGENT) * (1.0f / DM) + EPS);
                float* dst = yout + (size_t)row * DM + col0;
#pragma unroll
                for (int bj = 0; bj < 2; ++bj) { *(f32x4*)(dst + bj * HALF) = acc[ai][bj][m][0] * rstd * g[bj][0]; *(f32x4*)(dst + bj * HALF + 4) = acc[ai][bj][m][1] * rstd * g[bj][1]; }
            }
    }
};

__device__ __forceinline__ float conv_dpp(float acc0, float x, float w1, float w0, float p, float w1m, float w0m) {
    asm("s_nop 1\n\t"
        "v_fmac_f32_dpp %0, %1, %2 row_shr:1 row_mask:0xf bank_mask:0xf bound_ctrl:1\n\t"
        "v_fmac_f32_dpp %0, %1, %3 row_shr:2 row_mask:0xf bank_mask:0xf bound_ctrl:1\n\t"
        "v_fmac_f32_dpp %0, %4, %5 row_ror:1 row_mask:0xf bank_mask:0xf bound_ctrl:1\n\t"
        "v_fmac_f32_dpp %0, %4, %6 row_ror:2 row_mask:0xf bank_mask:0xf bound_ctrl:1"
        : "+v"(acc0) : "v"(x), "v"(w1), "v"(w0), "v"(p), "v"(w1m), "v"(w0m));
    return acc0;
}
__device__ __forceinline__ float conv_dpp2(float acc0, float x, float w1i, float w0i) {
    asm("s_nop 1\n\t"
        "v_fmac_f32_dpp %0, %1, %2 row_shr:1 row_mask:0xf bank_mask:0xf bound_ctrl:1\n\t"
        "v_fmac_f32_dpp %0, %1, %3 row_shr:2 row_mask:0xf bank_mask:0xf bound_ctrl:1"
        : "+v"(acc0) : "v"(x), "v"(w1i), "v"(w0i));
    return acc0;
}
typedef float f32x2 __attribute__((ext_vector_type(2)));
__device__ __forceinline__ f32x2 silu_gate_pk(f32x2 ca, f32x2 cb) {
    const f32x2 t = ca * -1.44269504f; f32x2 e; e.x = __builtin_amdgcn_exp2f(t.x); e.y = __builtin_amdgcn_exp2f(t.y);
    const f32x2 d = e + 1.0f; f32x2 s; s.x = __builtin_amdgcn_rcpf(d.x); s.y = __builtin_amdgcn_rcpf(d.y);
    return (ca * s) * cb;
}
struct EpiUp {
    const float* ss2; const float* cw; const float* st_ffn; bf16_t* actb; float* edge; float* first; float* nfp; float* nfs;

    __device__ __forceinline__ void prefetch(LAS unsigned char* lds, const Unit& u, int par, int wid, int) const {
        int lane; asm volatile("v_mbcnt_lo_u32_b32 %0, -1, 0\n\tv_mbcnt_hi_u32_b32 %0, -1, %0" : "=v"(lane));
        LAS unsigned char* tab = lds + TAB_OFF + par * TAB_BYTES;
        if (wid < 4) __builtin_amdgcn_global_load_lds((const unsigned*)(ss2 + u.pm * BM + wid * 64 + lane), (LAS unsigned*)(tab + wid * 256), 4, 0, 0);
        else if (wid < 7) { const int j = wid - 4, h = lane >> 5, i = lane & 31;
            __builtin_amdgcn_global_load_lds((const unsigned*)(cw + j * FF2 + h * FF + u.pn * 128 + 4 * i), (LAS unsigned*)(tab + 1024 + j * 1024), 16, 0, 0); }
    }
    template <bool SAMPLE>
    __device__ __forceinline__ void body(const f32x4 (&acc)[2][2][4][2], const Unit& u, int wr, int wc, int fr, int fq, LAS unsigned char* lds, int par) const {
        const int wid = wr * 4 + wc;
        const int f0 = u.pn * 128 + wc * 32 + 8 * fq;
        const int rowb = u.pm * BM + wr * 64 + fr;
        LAS float* xch = (LAS float*)(lds + STAGE_BYTES);
        LAS float* rtab = (LAS float*)(lds + RT_OFF);
        const LAS float* raw = (const LAS float*)(lds + TAB_OFF + par * TAB_BYTES);
        const LAS float* wt = raw + 256;
        if (wr == 0) { const int t = wc * 64 + fq * 16 + fr; rtab[t] = rsqrtf(raw[t] * (1.0f / DM) + EPS); }
        if (!SAMPLE) {
            if (fr >= 14) {
#pragma unroll
                for (int ai = 0; ai < 2; ++ai) {
                    LAS float* dst = xch + ((((wid * 2 + ai) * 4 + fq) * 2 + (fr - 14)) * 16);
                    const float r = rsqrtf(raw[wr * 64 + fr + ai * HALF + 48] * (1.0f / DM) + EPS);
#pragma unroll
                    for (int bj = 0; bj < 2; ++bj)
#pragma unroll
                        for (int n = 0; n < 2; ++n) *(LAS f32x4*)(dst + bj * 8 + n * 4) = acc[ai][bj][3][n] * r;
                }
            }
        }
        asm volatile("s_waitcnt lgkmcnt(0)" ::: "memory"); __builtin_amdgcn_s_barrier(); asm volatile("" ::: "memory");
        const int s8 = fr & 7;
#pragma unroll
        for (int n = 0; n < 2; ++n) {
            const int fn = f0 + 4 * n;
            f32x4 wa[3], wb[3];
#pragma unroll
            for (int j = 0; j < 3; ++j) { wa[j] = *(const LAS f32x4*)(wt + (j * 2 + 0) * 128 + wc * 32 + 8 * fq + 4 * n); wb[j] = *(const LAS f32x4*)(wt + (j * 2 + 1) * 128 + wc * 32 + 8 * fq + 4 * n); }
            const f32x4 z4w = (f32x4){0.f, 0.f, 0.f, 0.f};
            const bool k1 = SAMPLE ? (s8 >= 1) : (fr == 0), k0 = SAMPLE ? (s8 >= 2) : (fr < 2);
            const f32x4 wa1m = k1 ? wa[1] : z4w, wa0m = k0 ? wa[0] : z4w, wb1m = k1 ? wb[1] : z4w, wb0m = k0 ? wb[0] : z4w;
            f32x4 pa, pb;
#pragma unroll
            for (int ai = 0; ai < 2; ++ai) {
                if (!SAMPLE) {
                    if (ai == 0 && wr == 0) { pa = (f32x4){0.f, 0.f, 0.f, 0.f}; pb = pa; }
                    else {
                        const int swid = ((wr ^ 1) << 2) | wc, sai = (ai == 1 && wr == 1) ? 1 : 0;
                        const LAS float* src = xch + ((((swid * 2 + sai) * 4 + fq) * 2 + (fr & 1)) * 16);
                        pa = *(const LAS f32x4*)(src + 4 * n); pb = *(const LAS f32x4*)(src + 8 + 4 * n);
                    }
                }
#pragma unroll
                for (int m = 0; m < 4; ++m) {
                    const int row = rowb + ai * HALF + m * 16;
                    const float r = rtab[wr * 64 + fr + ai * HALF + m * 16];
                    const f32x4 va = acc[ai][0][m][n] * r, vb = acc[ai][1][m][n] * r;
                    f32x4 b1a, b2a, b1b, b2b;
                    const f32x4 z4 = (f32x4){0.f, 0.f, 0.f, 0.f};
                    if (SAMPLE) {
                        const int bseq = (row - NPR) >> 3;
                        const float* h0 = st_ffn + (size_t)bseq * 2 * FF2 + fn; const float* h1 = h0 + FF2;
                        b1a = z4; b2a = z4; b1b = z4; b2b = z4;
                        if (s8 < 2) {
                            const f32x4 h1a = *(const f32x4*)(h1), h1b = *(const f32x4*)(h1 + FF);
                            if (s8 == 0) { b1a = h1a; b1b = h1b; b2a = *(const f32x4*)(h0); b2b = *(const f32x4*)(h0 + FF); }
                            else { b2a = h1a; b2b = h1b; }
                        }
                    }
                    float act[4];
                    if (SAMPLE) {
                        const f32x4 ca0 = wa[2] * va, cb0 = wb[2] * vb;
                        float ca[4], cb[4];
#pragma unroll
                        for (int e = 0; e < 4; ++e) {
                            ca[e] = conv_dpp2(ca0[e], va[e], wa1m[e], wa0m[e]); ca[e] = fmaf(wa[1][e], b1a[e], ca[e]); ca[e] = fmaf(wa[0][e], b2a[e], ca[e]);
                            cb[e] = conv_dpp2(cb0[e], vb[e], wb1m[e], wb0m[e]); cb[e] = fmaf(wb[1][e], b1b[e], cb[e]); cb[e] = fmaf(wb[0][e], b2b[e], cb[e]); }
                        const f32x2 r01 = silu_gate_pk((f32x2){ca[0], ca[1]}, (f32x2){cb[0], cb[1]}), r23 = silu_gate_pk((f32x2){ca[2], ca[3]}, (f32x2){cb[2], cb[3]});
                        act[0] = r01.x; act[1] = r01.y; act[2] = r23.x; act[3] = r23.y;
                    } else {
                        const f32x4 ca0 = wa[2] * va, cb0 = wb[2] * vb;
                        float ca[4], cb[4];
#pragma unroll
                        for (int e = 0; e < 4; ++e) { ca[e] = conv_dpp(ca0[e], va[e], wa[1][e], wa[0][e], pa[e], wa1m[e], wa0m[e]); cb[e] = conv_dpp(cb0[e], vb[e], wb[1][e], wb[0][e], pb[e], wb1m[e], wb0m[e]); }
                        const f32x2 r01 = silu_gate_pk((f32x2){ca[0], ca[1]}, (f32x2){cb[0], cb[1]}), r23 = silu_gate_pk((f32x2){ca[2], ca[3]}, (f32x2){cb[2], cb[3]});
                        act[0] = r01.x; act[1] = r01.y; act[2] = r23.x; act[3] = r23.y;
                    }
                    { u32x2 w; w.x = cvt_pk_bf16(act[0], act[1]); w.y = cvt_pk_bf16(act[2], act[3]);
                      *(u32x2*)(actb + (((size_t)u.pm * (FF / BK) + (fn >> 6)) * BM + (row & 255)) * BK + (fn & 63)) = w; }
                    if (SAMPLE) {
                        if (s8 >= 6) { float* d = nfs + ((size_t)((row - NPR) >> 3) * 2 + (s8 - 6)) * FF2 + fn; *(f32x4*)(d) = va; *(f32x4*)(d + FF) = vb; }
                    } else {
                        if (ai == 1 && wr == 1 && m == 3 && fr >= 14) {
                            float* d = edge + ((size_t)u.pm * 2 + (fr - 14)) * FF2 + fn; *(f32x4*)(d) = va; *(f32x4*)(d + FF) = vb;
                            if ((u.pm & 7) == 7) { float* d2 = nfp + ((size_t)(u.pm >> 3) * 2 + (fr - 14)) * FF2 + fn; *(f32x4*)(d2) = va; *(f32x4*)(d2 + FF) = vb; }
                        }
                        if (ai == 0 && wr == 0 && m == 0 && fr < 2) { float* d = first + ((size_t)u.pm * 2 + fr) * FF2 + fn; *(f32x4*)(d) = va; *(f32x4*)(d + FF) = vb; }
                        pa = va; pb = vb;
                    }
                    __builtin_amdgcn_sched_barrier(0);
                }
            }
        }
    }
    __device__ __forceinline__ void operator()(const f32x4 (&acc)[2][2][4][2], const Unit& u, int wr, int wc, int fr_, int fq_, LAS unsigned char* lds, int ui, bool has_next, const Unit& nxt) const {
        int lane; asm volatile("v_mbcnt_lo_u32_b32 %0, -1, 0\n\tv_mbcnt_hi_u32_b32 %0, -1, %0" : "=v"(lane));
        const int fr = lane & 15, fq = lane >> 4;
        if (has_next) prefetch(lds, nxt, (ui + 1) & 1, wr * 4 + wc, lane);
        if (u.pm >= 64) body<true>(acc, u, wr, wc, fr, fq, lds, ui & 1); else body<false>(acc, u, wr, wc, fr, fq, lds, ui & 1);
    }
};

template <class Epi, bool TILED = false>
__device__ __forceinline__ void gemm_phase(LAS unsigned char* lds, const Gemm g, const StaticOrder& S, const Epi& E, int wv) {
    const int tid = opaque_tid(wv), wid = __builtin_amdgcn_readfirstlane(tid >> 6), lane = tid & 63, wr = wid >> 2, wc = wid & 3, fr = lane & 15, fq = lane >> 4;
    const int K = g.K;
    unsigned voffA[2], voffB[2];
#pragma unroll
    for (int i = 0; i < 2; ++i) { int R, C; stage_rc(tid * 16 + i * 8192, R, C); const int Rb = (R & ~31) + perm32(R & 31);
        const int P = TILED ? BK : K;
        voffA[i] = (unsigned)(R * P + C) * 2u; voffB[i] = (unsigned)(Rb * P + C) * 2u; }
    const size_t kstep = TILED ? (size_t)(BM * BK * 2) : (size_t)(BK * 2);
    const size_t hstep = TILED ? (size_t)(HALF * BK * 2) : (size_t)HALF * K * 2;
    const size_t tstep = TILED ? (size_t)(K / BK) * (BM * BK * 2) : 2 * hstep;
    const unsigned ldsw = (unsigned)wid * 1024u;
    const int aoff = lds_byte(wr * 64 + fr, fq * 8), boff = lds_byte(wc * 32 + fr, fq * 8);
#define PG8_SA(b, h) (((b) * 2 + (h)) * HTB)
#define PG8_SB(b, h) ((4 + (b) * 2 + (h)) * HTB)
#define PG8_STAGE(bufoff, gbase, voff) do { _Pragma("unroll") for (int _i = 0; _i < 2; ++_i) \
        __builtin_amdgcn_global_load_lds((const unsigned*)((const char*)(gbase) + (voff)[_i]), (LAS unsigned*)(lds + (bufoff) + ldsw + _i * 8192), 16, 0, 0); } while (0)
#define PG8_LDA(dst, b, h) do { _Pragma("unroll") for (int m = 0; m < 4; ++m) _Pragma("unroll") for (int k = 0; k < 2; ++k) dst[m][k] = *(const LAS bf16x8*)(lds + PG8_SA(b, h) + aoff + m * 2048 + k * 1024); } while (0)
#define PG8_LDB(dst, b, h) do { _Pragma("unroll") for (int n = 0; n < 2; ++n) _Pragma("unroll") for (int k = 0; k < 2; ++k) dst[n][k] = *(const LAS bf16x8*)(lds + PG8_SB(b, h) + boff + n * 2048 + k * 1024); } while (0)
#define PG8_MMA(ai, bj, At, Bt) do { __builtin_amdgcn_s_setprio(1); _Pragma("unroll") for (int m = 0; m < 4; ++m) _Pragma("unroll") for (int n = 0; n < 2; ++n) _Pragma("unroll") for (int k = 0; k < 2; ++k) \
        acc[ai][bj][m][n] = __builtin_amdgcn_mfma_f32_16x16x32_bf16(Bt[n][k], At[m][k], acc[ai][bj][m][n], 0, 0, 0); __builtin_amdgcn_s_setprio(0); } while (0)
#define PG8_WAIT_V(n) asm volatile("s_waitcnt vmcnt(" #n ")" ::: "memory")
#define PG8_WAIT_L(n) asm volatile("s_waitcnt lgkmcnt(" #n ")" ::: "memory")
#define PG8_BAR __builtin_amdgcn_s_barrier()
#define PG8_SCHED __builtin_amdgcn_sched_barrier(0)
    Unit cur, nxt; int ui = 0;
    if (!S.next(0, cur)) return;
    f32x4 acc[2][2][4][2];
#pragma unroll
    for (int a = 0; a < 2; ++a)
#pragma unroll
        for (int b = 0; b < 2; ++b)
#pragma unroll
            for (int m = 0; m < 4; ++m)
#pragma unroll
                for (int n = 0; n < 2; ++n) acc[a][b][m][n] = (f32x4){0.f, 0.f, 0.f, 0.f};
    bf16x8 At[4][2], B0[2][2], B1[2][2];
    const char* cA = (const char*)g.A + (size_t)cur.pm * tstep + (size_t)cur.kt0 * kstep; const char* cB = (const char*)g.Bt + (size_t)cur.pn * tstep + (size_t)cur.kt0 * kstep;
    E.prefetch(lds, cur, 0, wid, lane);
    PG8_STAGE(PG8_SB(0, 0), cB, voffB); PG8_STAGE(PG8_SA(0, 0), cA, voffA); PG8_STAGE(PG8_SB(0, 1), cB + hstep, voffB); PG8_STAGE(PG8_SA(0, 1), cA + hstep, voffA);
    if (wr == 1) PG8_BAR;
    PG8_WAIT_V(4); PG8_BAR;
    PG8_STAGE(PG8_SB(1, 0), cB + kstep, voffB); PG8_STAGE(PG8_SA(1, 0), cA + kstep, voffA); PG8_STAGE(PG8_SB(1, 1), cB + hstep + kstep, voffB);
    PG8_WAIT_V(6); PG8_BAR;
    for (;;) {
        const bool has_next = S.next(ui + 1, nxt);
        const char* nA = has_next ? (const char*)g.A + (size_t)nxt.pm * tstep + (size_t)nxt.kt0 * kstep : cA; const char* nB = has_next ? (const char*)g.Bt + (size_t)nxt.pn * tstep + (size_t)nxt.kt0 * kstep : cB;
        const int nt = cur.nkt;
        for (int t = 0; t < nt; t += 2) {
            const bool last = (t == nt - 2);
            const char* a1 = cA + (size_t)(t + 1) * kstep;
            const char* a2 = last ? nA : cA + (size_t)(t + 2) * kstep; const char* b2 = last ? nB : cB + (size_t)(t + 2) * kstep;
            const char* a3 = a2 + kstep; const char* b3 = b2 + kstep;
            PG8_LDB(B0, 0, 0); PG8_SCHED; PG8_LDA(At, 0, 0); PG8_STAGE(PG8_SA(1, 1), a1 + hstep, voffA);
            PG8_WAIT_L(8); PG8_BAR; PG8_WAIT_L(0); PG8_MMA(0, 0, At, B0); PG8_BAR; PG8_SCHED;
            PG8_LDB(B1, 0, 1); PG8_STAGE(PG8_SB(0, 0), b2, voffB);
            PG8_BAR; PG8_WAIT_L(0); PG8_MMA(0, 1, At, B1); PG8_BAR;
            PG8_LDA(At, 0, 1); PG8_STAGE(PG8_SA(0, 0), a2, voffA);
            PG8_BAR; PG8_WAIT_L(0); PG8_MMA(1, 0, At, B0); PG8_BAR; PG8_SCHED;
            PG8_STAGE(PG8_SB(0, 1), b2 + hstep, voffB);
            PG8_WAIT_V(6); PG8_BAR; PG8_MMA(1, 1, At, B1); PG8_BAR;
            PG8_LDB(B0, 1, 0); PG8_SCHED; PG8_LDA(At, 1, 0); PG8_STAGE(PG8_SA(0, 1), a2 + hstep, voffA);
            PG8_WAIT_L(8); PG8_BAR; PG8_WAIT_L(0); PG8_MMA(0, 0, At, B0); PG8_BAR; PG8_SCHED;
            PG8_LDB(B1, 1, 1); PG8_STAGE(PG8_SB(1, 0), b3, voffB);
            PG8_BAR; PG8_WAIT_L(0); PG8_MMA(0, 1, At, B1); PG8_BAR;
            PG8_LDA(At, 1, 1); PG8_STAGE(PG8_SA(1, 0), a3, voffA);
            PG8_BAR; PG8_WAIT_L(0); PG8_MMA(1, 0, At, B0); PG8_BAR; PG8_SCHED;
            PG8_STAGE(PG8_SB(1, 1), b3 + hstep, voffB);
            PG8_WAIT_V(6); PG8_BAR; PG8_MMA(1, 1, At, B1); PG8_BAR;
        }
        if (wr == 0) PG8_BAR;
        asm volatile("" ::: "memory");
        E(acc, cur, wr, wc, fr, fq, lds, ui, has_next, nxt);
        if (!has_next) break;
#pragma unroll
        for (int a = 0; a < 2; ++a)
#pragma unroll
            for (int b = 0; b < 2; ++b)
#pragma unroll
                for (int m = 0; m < 4; ++m)
#pragma unroll
                    for (int n = 0; n < 2; ++n) acc[a][b][m][n] = (f32x4){0.f, 0.f, 0.f, 0.f};
        cur = nxt; cA = nA; cB = nB; ++ui;
        asm volatile("" ::: "memory");
        if (wr == 1) PG8_BAR;
    }
    PG8_WAIT_V(0);
    PG8_BAR;
#undef PG8_SA
#undef PG8_SB
#undef PG8_STAGE
#undef PG8_LDA
#undef PG8_LDB
#undef PG8_MMA
#undef PG8_WAIT_V
#undef PG8_WAIT_L
#undef PG8_BAR
#undef PG8_SCHED
}

#define LDS_WAIT() asm volatile("s_waitcnt lgkmcnt(0)" ::: "memory")
template <int MODE>
__device__ __forceinline__ void p0_transpose_item(const float* W, int K, int N, const float* gain, bf16_t* WT, LAS float* scr, int item, int lane) {
    const int nblk = N / 32, kb = item / nblk, nb = item % nblk, k0 = 64 * kb, n0 = 32 * nb;
    { f32x4 t4[8];
#pragma unroll
      for (int i = 0; i < 8; ++i) { const int kk = 8 * i + (lane >> 3); t4[i] = __builtin_nontemporal_load((const f32x4*)(W + (size_t)(k0 + kk) * N + n0 + (lane & 7) * 4)); if (gain) t4[i] = t4[i] * gain[k0 + kk]; }
#pragma unroll
      for (int i = 0; i < 8; ++i) { const int kk = 8 * i + (lane >> 3); LAS float* d = scr + kk * 33 + (lane & 7) * 4; d[0] = t4[i][0]; d[1] = t4[i][1]; d[2] = t4[i][2]; d[3] = t4[i][3]; } }
    LDS_WAIT(); asm volatile("" ::: "memory");
    const int c = lane & 7;
#pragma unroll
    for (int j = 0; j < 4; ++j) { const int n = (lane >> 3) + 8 * j; const LAS float* s = scr + (8 * c) * 33 + n;
        u32x4 o; o.x = cvt_pk_bf16(s[0 * 33], s[1 * 33]); o.y = cvt_pk_bf16(s[2 * 33], s[3 * 33]); o.z = cvt_pk_bf16(s[4 * 33], s[5 * 33]); o.w = cvt_pk_bf16(s[6 * 33], s[7 * 33]);
        int row = n0 + n;
        if (MODE == 2) { const int half = row >= FF ? 1 : 0, f = row - half * FF; row = (f >> 7) * 256 + half * 128 + (f & 127); }
        if (MODE == 4 && row >= 1024) { const int half = row >= 1536 ? 1 : 0, f = row - 1024 - half * 512; row = 1024 + (f >> 7) * 256 + half * 128 + (f & 127); }
        if (MODE == 3) *(u32x4*)(WT + ((((size_t)(row >> 8) * (K / BK) + (k0 >> 6)) * BM + (row & 255)) * BK + 8 * c)) = o;
        else *(u32x4*)(WT + (size_t)row * K + k0 + 8 * c) = o; }
    LDS_WAIT(); asm volatile("" ::: "memory");
}

template <int PART>
__device__ __forceinline__ void prep_items(const Params& p, LAS unsigned char* lds, int wave, int lane, int gw, int NGW) {
    bf16_t* Wt_in = (bf16_t*)(p.ws + WS_WIN); bf16_t* Wt_out = (bf16_t*)(p.ws + WS_WOUT); bf16_t* Wt_up = (bf16_t*)(p.ws + WS_WUP); bf16_t* Wt_dn = (bf16_t*)(p.ws + WS_WDN);
    bf16_t* hb = (bf16_t*)(p.ws + WS_HB);
    LAS float* scr = (LAS float*)(lds + wave * 16384);
    constexpr int I_FOLD = 1024, I_IN = 16 * 64, I_OUT = 8 * 32, I_UP = 16 * 176, I_DN = 44 * 32, I_ROWS = NTOK / 2;
    constexpr int NITEMS = PART == 0 ? I_IN + I_ROWS : PART == 1 ? I_FOLD + I_OUT : PART == 2 ? I_UP : I_DN;
    for (int it = gw; it < NITEMS; it += NGW) {
        int r = it;
        if (PART == 1) {
            if (r < I_FOLD) {
                const int cblk = r >> 4, n = (r & 15) * 64 + lane, g = cblk >> 4, c0 = (cblk & 15) * 8;
                float a8[8];
#pragma unroll
                for (int e = 0; e < 8; ++e) a8[e] = 0.f;
                const float* wg = p.w_grp + (size_t)(g * 128 + c0) * 128;
#pragma unroll 1
                for (int d0 = 0; d0 < 128; d0 += 16) {
                    float av[16];
#pragma unroll
                    for (int j = 0; j < 16; ++j) av[j] = p.w_out[(size_t)(g * 128 + d0 + j) * DM + n] * p.pool_scale[g * 128 + d0 + j];
#pragma unroll
                    for (int j = 0; j < 16; ++j)
#pragma unroll
                        for (int e = 0; e < 8; ++e) a8[e] = fmaf(wg[e * 128 + d0 + j], av[j], a8[e]);
                }
                *(u32x4*)(Wt_out + (size_t)n * DM + g * 128 + c0) = pack8(a8);
                continue;
            }
            r -= I_FOLD;
            p0_transpose_item<0>(p.w_out + (size_t)512 * DM, DM, DM, nullptr, Wt_out + 512, scr, r, lane);
            continue;
        }
        if (PART == 2) { p0_transpose_item<2>(p.w_up, DM, FF2, p.g2, Wt_up, scr, r, lane); continue; }
        if (PART == 3) { p0_transpose_item<3>(p.w_down, FF, DM, nullptr, Wt_dn, scr, r, lane); continue; }
        if (r < I_IN) { p0_transpose_item<4>(p.w_in, DM, INW, p.g1, Wt_in, scr, r, lane); continue; } r -= I_IN;
        {
            f32x4 v[2][4]; float s[2];
#pragma unroll
            for (int q = 0; q < 2; ++q) { const int row = 2 * r + q; const float* xr = row < NPR ? p.x_prompt + (size_t)row * DM : p.x_sample + (size_t)(row - NPR) * DM;
#pragma unroll
                for (int j = 0; j < 4; ++j) v[q][j] = __builtin_nontemporal_load((const f32x4*)xr + lane + 64 * j); }
#pragma unroll
            for (int q = 0; q < 2; ++q) { s[q] = 0.f;
#pragma unroll
                for (int j = 0; j < 4; ++j) s[q] += (v[q][j][0] * v[q][j][0] + v[q][j][1] * v[q][j][1]) + (v[q][j][2] * v[q][j][2] + v[q][j][3] * v[q][j][3]); }
#pragma unroll
            for (int q = 0; q < 2; ++q) { const float ms = wave_sum(s[q]) * (1.0f / DM) + EPS; const float rstd = rsqrtf(ms);
                if (lane == 0) ((float*)(p.ws + WS_RINV))[2 * r + q] = ms * rstd;
                u32x2* o = (u32x2*)(hb + (size_t)(2 * r + q) * DM) + lane;
#pragma unroll
                for (int j = 0; j < 4; ++j) { u32x2 w; w.x = cvt_pk_bf16(v[q][j][0] * rstd, v[q][j][1] * rstd); w.y = cvt_pk_bf16(v[q][j][2] * rstd, v[q][j][3] * rstd); o[64 * j] = w; } }
        }
    }
}
__device__ __forceinline__ void phase0(const Params& p, LAS unsigned char* lds, int wv) {
    const int tid = opaque_tid(wv), lane = tid & 63;
    const int G = gridDim.x;
    float* ss = (float*)(p.ws + WS_SS);
    for (int i = blockIdx.x * 512 + tid; i < 2 * NTOK; i += G * 512) ss[i] = 0.f;
    { unsigned* cz = (unsigned*)(p.ws + WS_CNT); for (int i = blockIdx.x * 512 + tid; i < 64 * 64; i += G * 512) cz[i] = 0u; }
    prep_items<0>(p, lds, wv, lane, blockIdx.x * 8 + wv, G * 8);
}
template <int PART>
__device__ __forceinline__ void prep_in_idle(const Params& p, LAS unsigned char* lds, int wv, const StaticOrder& S) {
    const int nbusy = S.nwg % S.G;
    if (nbusy == 0) { prep_items<PART>(p, lds, wv, opaque_tid(wv) & 63, blockIdx.x * 8 + wv, S.G * 8); return; }
    if ((int)blockIdx.x < nbusy) return;
    prep_items<PART>(p, lds, wv, opaque_tid(wv) & 63, ((int)blockIdx.x - nbusy) * 8 + wv, (S.G - nbusy) * 8);
}

__device__ __forceinline__ void ld8(const bf16_t* p, float (&f)[8]) { unpack8(*(const u32x4*)p, f); }
__device__ __forceinline__ void ld8f(const float* p, float (&f)[8]) { const f32x4 a = *(const f32x4*)p, b = *(const f32x4*)(p + 4); f[0] = a[0]; f[1] = a[1]; f[2] = a[2]; f[3] = a[3]; f[4] = b[0]; f[5] = b[1]; f[6] = b[2]; f[7] = b[3]; }
__device__ __forceinline__ void st8f(float* p, const float (&f)[8]) { *(f32x4*)p = (f32x4){f[0], f[1], f[2], f[3]}; *(f32x4*)(p + 4) = (f32x4){f[4], f[5], f[6], f[7]}; }

__device__ __forceinline__ void p2_prompt_item(const Params& p, const bf16_t* zb, bf16_t* A2, int chunk_, int v) {
    const int chunk = __builtin_amdgcn_readfirstlane(chunk_);
    const int seq = chunk >> 7, t0 = (chunk & 127) * 16;
    const size_t r0 = (size_t)seq * SEQL + t0;
    if (v < 64) {
        const int c = v * 8, g = v >> 4, win = 2 << g;
        const bf16_t* base = zb + r0 * ZP + c;
        bf16_t* ob = A2 + r0 * DM + c;
        float S[8];
#pragma unroll
        for (int e = 0; e < 8; ++e) S[e] = 0.f;
        {
            u32x4 w[15];
#pragma unroll
            for (int k = 1; k < 16; ++k) { w[k - 1] = (u32x4){0u, 0u, 0u, 0u}; if (k < win && t0 > 0) w[k - 1] = *(const u32x4*)(base - (ptrdiff_t)k * ZP); }
#pragma unroll
            for (int k = 0; k < 15; ++k) { float f[8]; unpack8(w[k], f);
#pragma unroll
                for (int e = 0; e < 8; ++e) S[e] += f[e]; }
        }
#pragma unroll
        for (int h = 0; h < 2; ++h) {
            u32x4 cw_[8], ow[8];
#pragma unroll
            for (int i = 0; i < 8; ++i) { const int ri = 8 * h + i, t = t0 + ri;
                cw_[i] = *(const u32x4*)(base + (ptrdiff_t)ri * ZP);
                ow[i] = (u32x4){0u, 0u, 0u, 0u}; if (ri >= 1 && t - win >= 0) ow[i] = *(const u32x4*)(base + (ptrdiff_t)(ri - win) * ZP); }
#pragma unroll
            for (int i = 0; i < 8; ++i) { const int ri = 8 * h + i, t = t0 + ri;
                float cur[8], old[8], d[8]; unpack8(cw_[i], cur); unpack8(ow[i], old);
                const float inv = 1.0f / (float)min(t + 1, win);
#pragma unroll
                for (int e = 0; e < 8; ++e) { S[e] += cur[e] - old[e]; d[e] = S[e] * inv - cur[e]; }
                *(u32x4*)(ob + (size_t)ri * DM) = pack8(d);
                if (t >= SEQL - 15) st8f(p.out + O_NPP + ((size_t)seq * 15 + (t - (SEQL - 15))) * 512 + c, cur); }
        }
    } else {
        const int c = (v - 64) * 8;
        const bf16_t* base = zb + r0 * ZP + c;
        bf16_t* ob = A2 + r0 * DM + 512 + c;
        float vm2[8], vm1[8], w0[8], w1[8], w2[8];
        ld8f(p.conv_w + c, w0); ld8f(p.conv_w + 512 + c, w1); ld8f(p.conv_w + 1024 + c, w2);
        if (t0 > 0) { ld8(base - 2 * ZP + 1024, vm2); ld8(base - ZP + 1024, vm1); }
        else {
#pragma unroll
            for (int e = 0; e < 8; ++e) { vm2[e] = 0.f; vm1[e] = 0.f; } }
#pragma unroll
        for (int h = 0; h < 2; ++h) {
            u32x4 gbw[8], vw[8];
#pragma unroll
            for (int i = 0; i < 8; ++i) { const bf16_t* zr = base + (size_t)(8 * h + i) * ZP; gbw[i] = *(const u32x4*)(zr + 512); vw[i] = *(const u32x4*)(zr + 1024); }
#pragma unroll
            for (int i = 0; i < 8; ++i) { const int ri = 8 * h + i, t = t0 + ri;
                float gb[8], vc[8], y[8]; unpack8(gbw[i], gb); unpack8(vw[i], vc);
#pragma unroll
                for (int e = 0; e < 8; ++e) { y[e] = gb[e] * (w0[e] * vm2[e] + w1[e] * vm1[e] + w2[e] * vc[e]); vm2[e] = vm1[e]; vm1[e] = vc[e]; }
                *(u32x4*)(ob + (size_t)ri * DM) = pack8(y);
                if (t >= SEQL - 2) st8f(p.out + O_NCP + ((size_t)seq * 2 + (t - (SEQL - 2))) * 512 + c, vc); }
        }
    }
}
__device__ __forceinline__ void p2_sample_item(const Params& p, const bf16_t* zb, bf16_t* A2, int rr, int v) {
    const int bq = rr >> 3, t = rr & 7; const size_t r = (size_t)NPR + rr;
    if (v < 64) {
        const int c = v * 8, g = v >> 4, win = 2 << g;
        const bf16_t* base = zb + r * ZP + c;
        float sum[8], cur[8];
        u32x4 w[8];
#pragma unroll
        for (int k = 0; k < 8; ++k) { w[k] = (u32x4){0u, 0u, 0u, 0u}; if (k < win && k <= t) w[k] = *(const u32x4*)(base - (ptrdiff_t)k * ZP); }
        unpack8(w[0], cur);
#pragma unroll
        for (int e = 0; e < 8; ++e) sum[e] = cur[e];
#pragma unroll
        for (int k = 1; k < 8; ++k) { float f[8]; unpack8(w[k], f);
#pragma unroll
            for (int e = 0; e < 8; ++e) sum[e] += f[e]; }
        const float* hb_ = p.st_pool + (size_t)bq * 15 * 512 + c;
#pragma unroll
        for (int hh = 0; hh < 3; ++hh) {
            f32x4 ha[5], hb2[5];
#pragma unroll
            for (int q = 0; q < 5; ++q) { const int j = hh * 5 + q; ha[q] = (f32x4){0.f, 0.f, 0.f, 0.f}; hb2[q] = ha[q];
                if (j >= 16 + t - win) { ha[q] = *(const f32x4*)(hb_ + (size_t)j * 512); hb2[q] = *(const f32x4*)(hb_ + (size_t)j * 512 + 4); } }
#pragma unroll
            for (int q = 0; q < 5; ++q) {
#pragma unroll
                for (int e = 0; e < 4; ++e) { sum[e] += ha[q][e]; sum[4 + e] += hb2[q][e]; } }
        }
        const float inv = 1.0f / (float)win;
        float d[8], tmp[8];
#pragma unroll
        for (int e = 0; e < 8; ++e) d[e] = sum[e] * inv - cur[e];
        *(u32x4*)(A2 + r * DM + c) = pack8(d);
        st8f(p.out + O_NPS + ((size_t)bq * 15 + 7 + t) * 512 + c, cur);
        if (t < 7) { ld8f(p.st_pool + ((size_t)bq * 15 + 8 + t) * 512 + c, tmp); st8f(p.out + O_NPS + ((size_t)bq * 15 + t) * 512 + c, tmp); }
    } else {
        const int c = (v - 64) * 8;
        float gb[8], v0[8], v1[8], v2[8], w0[8], w1[8], w2[8];
        const bf16_t* zr = zb + r * ZP + c;
        ld8(zr + 512, gb); ld8(zr + 1024, v2);
        if (t >= 1) ld8(zr - ZP + 1024, v1);
        else ld8f(p.st_conv + ((size_t)bq * 2 + 1) * 512 + c, v1);
        if (t >= 2) ld8(zr - 2 * ZP + 1024, v0);
        else ld8f(p.st_conv + ((size_t)bq * 2 + t) * 512 + c, v0);
        ld8f(p.conv_w + c, w0); ld8f(p.conv_w + 512 + c, w1); ld8f(p.conv_w + 1024 + c, w2);
        float y[8];
#pragma unroll
        for (int e = 0; e < 8; ++e) y[e] = gb[e] * (w0[e] * v0[e] + w1[e] * v1[e] + w2[e] * v2[e]);
        *(u32x4*)(A2 + r * DM + 512 + c) = pack8(y);
        if (t >= 6) st8f(p.out + O_NCS + ((size_t)bq * 2 + (t - 6)) * 512 + c, v2);
    }
}
__device__ __forceinline__ void phase2(const Params& p, int wv) {
    const bf16_t* zb = (const bf16_t*)(p.ws + WS_ZB); bf16_t* A2 = (bf16_t*)(p.ws + WS_A2);
    const int tid0 = blockIdx.x * 512 + opaque_tid(wv);
    for (int it = tid0; it < 1024 * 128; it += gridDim.x * 512) p2_prompt_item(p, zb, A2, it >> 7, it & 127);
    for (int it = tid0; it < 1024 * 128; it += gridDim.x * 512) p2_sample_item(p, zb, A2, it >> 7, it & 127);
}

__device__ __forceinline__ void fixup_rows(const Params& p, int pm, int tid) {
    if (tid >= FF / 8) return;
    const int f0 = tid * 8;
    const float* edge = (const float*)(p.ws + WS_EDGE) + (size_t)(pm - 1) * 2 * FF2 + f0;
    const float* first = (const float*)(p.ws + WS_FIRST) + (size_t)pm * 2 * FF2 + f0;
    bf16_t* actb = (bf16_t*)(p.ws + WS_ACT) + (((size_t)pm * (FF / BK) + (f0 >> 6)) * BM) * BK + (f0 & 63);
    float act0[8], act1[8];
    float ca0[8], ca1[8];
#pragma unroll
    for (int h = 0; h < 2; ++h) {
        float e0[8], e1[8], x0[8], x1[8], w0[8], w1[8], w2[8];
        ld8f(edge + h * FF, e0); ld8f(edge + FF2 + h * FF, e1); ld8f(first + h * FF, x0); ld8f(first + FF2 + h * FF, x1);
        ld8f(p.ffn_cw + h * FF + f0, w0); ld8f(p.ffn_cw + FF2 + h * FF + f0, w1); ld8f(p.ffn_cw + 2 * FF2 + h * FF + f0, w2);
#pragma unroll
        for (int e = 0; e < 8; ++e) {
            const float c0 = w0[e] * e0[e] + w1[e] * e1[e] + w2[e] * x0[e];
            const float c1 = w0[e] * e1[e] + w1[e] * x0[e] + w2[e] * x1[e];
            if (h == 0) { ca0[e] = c0; ca1[e] = c1; }
            else {
                act0[e] = ca0[e] * __builtin_amdgcn_rcpf(1.0f + __builtin_amdgcn_exp2f(ca0[e] * -1.44269504f)) * c0;
                act1[e] = ca1[e] * __builtin_amdgcn_rcpf(1.0f + __builtin_amdgcn_exp2f(ca1[e] * -1.44269504f)) * c1;
            }
        }
    }
    *(u32x4*)(actb) = pack8(act0); *(u32x4*)(actb + BK) = pack8(act1);
}

__device__ __forceinline__ void phase6(const Params& p, int wv) {
    const int lane = opaque_tid(wv) & 63;
    const bool split = (P5_SPLIT && gridDim.x == 256);
    const int gw = blockIdx.x * 8 + wv, NGW = gridDim.x * 8;
    const bf16_t* x2b = (const bf16_t*)(p.ws + WS_X2B); const bf16_t* x1b = (const bf16_t*)(p.ws + WS_X1B);
    const float* part = (const float*)(p.ws + WS_PART);
    float g[16];
    ld8f(p.gf + 8 * lane, *(float (*)[8])&g[0]); ld8f(p.gf + 512 + 8 * lane, *(float (*)[8])&g[8]);
    for (int r2 = (split ? NPR / 2 : 0) + gw; r2 < NTOK / 2; r2 += NGW) {
        u32x4 w[2][2];
        const bool slices = split && 2 * r2 >= NPR;
        const bf16_t* srcb = slices ? x1b : x2b;
#pragma unroll
        for (int q = 0; q < 2; ++q) { w[q][0] = *(const u32x4*)(srcb + (size_t)(2 * r2 + q) * DM + 8 * lane); w[q][1] = *(const u32x4*)(srcb + (size_t)(2 * r2 + q) * DM + 512 + 8 * lane); }
        float v[2][16];
#pragma unroll
        for (int q = 0; q < 2; ++q) { unpack8(w[q][0], *(float (*)[8])&v[q][0]); unpack8(w[q][1], *(float (*)[8])&v[q][8]); }
        if (slices) {
#pragma unroll 2
            for (int ks = 0; ks < 8; ++ks)
#pragma unroll
                for (int q = 0; q < 2; ++q) { const float* pr = part + ((size_t)ks * 1024 + (2 * r2 + q - NPR)) * DM + 8 * lane;
                    float t[16]; ld8f(pr, *(float (*)[8])&t[0]); ld8f(pr + 512, *(float (*)[8])&t[8]);
#pragma unroll
                    for (int e = 0; e < 16; ++e) v[q][e] += t[e]; }
        }
#pragma unroll
        for (int q = 0; q < 2; ++q) { float s = 0.f;
#pragma unroll
            for (int e = 0; e < 16; ++e) s += v[q][e] * v[q][e];
            const float rstd = rsqrtf(wave_sum(s) * (1.0f / DM) + EPS);
            float o[16];
#pragma unroll
            for (int e = 0; e < 16; ++e) o[e] = v[q][e] * rstd * g[e];
            float* dst = p.out + (size_t)(2 * r2 + q) * DM + 8 * lane;
            st8f(dst, *(const float (*)[8])&o[0]); st8f(dst + 512, *(const float (*)[8])&o[8]); }
    }
}

template <int PH>
__device__ __forceinline__ void run_phase(const Params& p, LAS unsigned char* lds, int wv) {
    StaticOrder S;
    if (PH == 0) phase0(p, lds, wv);
    if (PH == 1) { Gemm g{(const bf16_t*)(p.ws + WS_HB), (const bf16_t*)(p.ws + WS_WIN), NTOK, INW, DM}; S.init(NTOK, INW, DM, gridDim.x, blockIdx.x, 0);
        EpiZ E{(bf16_t*)(p.ws + WS_ZB), ZP}; gemm_phase(lds, g, S, E, wv);
        prep_in_idle<1>(p, lds, wv, S); prep_in_idle<2>(p, lds, wv, S); }
    if (PH == 2) phase2(p, wv);
    if (PH == 3) { Gemm g{(const bf16_t*)(p.ws + WS_A2), (const bf16_t*)(p.ws + WS_WOUT), NTOK, DM, DM}; S.init(NPR, DM, DM, gridDim.x, blockIdx.x, 0);
        EpiRes<false> E{(const float*)(p.ws + WS_RINV), (const bf16_t*)(p.ws + WS_HB), (bf16_t*)(p.ws + WS_X1B), (float*)(p.ws + WS_SS), DM / BK, nullptr}; gemm_phase(lds, g, S, E, wv); }
    if (PH == 4) {
        const int G = gridDim.x, c = blockIdx.x;
        unsigned* ready = (unsigned*)(p.ws + WS_BAR);
        if (c >= G - 16) {
            const int j = c - (G - 16);
            Gemm g3{(const bf16_t*)(p.ws + WS_A2), (const bf16_t*)(p.ws + WS_WOUT), NTOK, DM, DM}; StaticOrder S1; S1.init(NTOK, DM, DM, G, c, 2); S1.spm = 64 + (j >> 2); S1.spn = j & 3;
            EpiRes<false> E3{(const float*)(p.ws + WS_RINV), (const bf16_t*)(p.ws + WS_HB), (bf16_t*)(p.ws + WS_X1B), (float*)(p.ws + WS_SS), DM / BK, nullptr}; gemm_phase(lds, g3, S1, E3, wv);
            __threadfence(); __syncthreads();
            if (opaque_tid(wv) == 0) __hip_atomic_fetch_add(ready, 1u, __ATOMIC_RELAXED, __HIP_MEMORY_SCOPE_AGENT);
        }
        Gemm g{(const bf16_t*)(p.ws + WS_X1B), (const bf16_t*)(p.ws + WS_WUP), NTOK, FF2, DM}; S.init(NPR, FF2, DM, G, c, 0);
        EpiUp E{(const float*)(p.ws + WS_SS), p.ffn_cw, p.st_ffn, (bf16_t*)(p.ws + WS_ACT), (float*)(p.ws + WS_EDGE), (float*)(p.ws + WS_FIRST), p.out + O_NFP, p.out + O_NFS}; gemm_phase(lds, g, S, E, wv);
        const int nfull = S.nwg % G;
        if (c >= nfull && c < nfull + 88 && c < G - 16) {
            if (wv == 0) {
                unsigned polls = 0;
                while ((unsigned)__builtin_amdgcn_readfirstlane(__hip_atomic_load(ready, __ATOMIC_RELAXED, __HIP_MEMORY_SCOPE_AGENT)) < 16u) { __builtin_amdgcn_s_sleep(4); if (++polls > (1u << 17)) break; }
                __builtin_amdgcn_fence(__ATOMIC_ACQUIRE, "agent");
                asm volatile("s_waitcnt vmcnt(0)" ::: "memory");
            }
            __syncthreads();
            const int idx = c - nfull;
            StaticOrder S2; S2.init(NTOK, FF2, DM, G, c, 2); S2.spm = 64 + idx / 22; S2.spn = idx % 22;
            gemm_phase(lds, g, S2, E, wv);
        } else if (c >= nfull + 88 && c < G - 16) {
            prep_items<3>(p, lds, wv, opaque_tid(wv) & 63, (c - nfull - 88) * 8 + wv, (G - 16 - nfull - 88) * 8);
        }
    }
    if (PH == 5) { Gemm g{(const bf16_t*)(p.ws + WS_ACT), (const bf16_t*)(p.ws + WS_WDN), NTOK, DM, FF};
        S.init(NTOK, DM, FF, gridDim.x, blockIdx.x, (P5_SPLIT && gridDim.x == 256) ? 1 : 0);
        { Unit u; for (int i = 0; S.next(i, u); ++i) if (u.pm < 64 && (u.pm & 7) != 0) fixup_rows(p, u.pm, opaque_tid(wv)); }
        asm volatile("s_waitcnt vmcnt(0)" ::: "memory"); __syncthreads();
        if (S.split == 1) { EpiDownFused E{(const bf16_t*)(p.ws + WS_X1B), p.out, p.gf, (float*)(p.ws + WS_SS) + NTOK, (unsigned*)(p.ws + WS_CNT), FF / BK, (float*)(p.ws + WS_PART)}; gemm_phase<EpiDownFused, true>(lds, g, S, E, wv); }
        else { EpiRes<true> E{nullptr, (const bf16_t*)(p.ws + WS_X1B), (bf16_t*)(p.ws + WS_X2B), nullptr, FF / BK, (float*)(p.ws + WS_PART)}; gemm_phase<EpiRes<true>, true>(lds, g, S, E, wv); } }
    if (PH == 6) phase6(p, wv);
}

extern __shared__ __attribute__((aligned(16))) unsigned char g_shm[];

template <int PH> __global__ __launch_bounds__(512, 2) void k_phase(Params p) { run_phase<PH>(p, (LAS unsigned char*)g_shm, __builtin_amdgcn_readfirstlane(threadIdx.x >> 6)); }

#if !MULTI_LAUNCH
__global__ __launch_bounds__(512, 2) void k_mega(Params p) {
    cg::grid_group grid = cg::this_grid();
    LAS unsigned char* lds = (LAS unsigned char*)g_shm;
    if (p.ws == nullptr) grid.sync();
    const int wv = __builtin_amdgcn_readfirstlane(threadIdx.x >> 6);
    volatile LAS unsigned* st = (volatile LAS unsigned*)(lds + STAGE_BYTES + XCH_BYTES);
    const int tid_ = opaque_tid(wv);
    if (tid_ == 0) { st[0] = 0u; st[1] = 0u; st[2] = 0u; st[3] = 0u; }
    __syncthreads();
    const XcdBarrier xb = xcd_barrier_post((unsigned*)(p.ws + WS_BAR), st, tid_);
    run_phase<0>(p, lds, wv); xcd_barrier(xb, wv);
    if (DUP_PHASE == 0) { run_phase<0>(p, lds, wv); xcd_barrier(xb, wv); }
    run_phase<1>(p, lds, wv); xcd_barrier(xb, wv);
    if (DUP_PHASE == 1) { run_phase<1>(p, lds, wv); xcd_barrier(xb, wv); }
    run_phase<2>(p, lds, wv); xcd_barrier(xb, wv);
    if (DUP_PHASE == 2) { run_phase<2>(p, lds, wv); xcd_barrier(xb, wv); }
    run_phase<3>(p, lds, wv); xcd_barrier(xb, wv);
    if (DUP_PHASE == 3) { { float* ss = (float*)(p.ws + WS_SS); for (int i = blockIdx.x * 512 + opaque_tid(wv); i < NTOK; i += gridDim.x * 512) ss[i] = 0.f; } xcd_barrier(xb, wv); run_phase<3>(p, lds, wv); xcd_barrier(xb, wv); }
    run_phase<4>(p, lds, wv); xcd_barrier(xb, wv);
    if (DUP_PHASE == 4) { run_phase<4>(p, lds, wv); xcd_barrier(xb, wv); }
    run_phase<5>(p, lds, wv); xcd_barrier(xb, wv);
    if (DUP_PHASE == 5) { run_phase<5>(p, lds, wv); xcd_barrier(xb, wv); }
    run_phase<6>(p, lds, wv);
    if (DUP_PHASE == 6) { xcd_barrier(xb, wv); run_phase<6>(p, lds, wv); }
}
#endif

extern "C" void kernel_launch(void* const* d_in, const int* in_sizes, int n_in, void* d_out, int out_size, void* d_ws, size_t ws_size, hipStream_t stream) {
    static int grid = 0;
    if (grid == 0) {
        int dev = 0, cus = 0, per_cu = 0;
        hipGetDevice(&dev);
        hipDeviceGetAttribute(&cus, hipDeviceAttributeMultiprocessorCount, dev);
#if MULTI_LAUNCH
        hipFuncSetAttribute((const void*)k_phase<0>, hipFuncAttributeMaxDynamicSharedMemorySize, LDS_BYTES);
        hipFuncSetAttribute((const void*)k_phase<1>, hipFuncAttributeMaxDynamicSharedMemorySize, LDS_BYTES);
        hipFuncSetAttribute((const void*)k_phase<2>, hipFuncAttributeMaxDynamicSharedMemorySize, LDS_BYTES);
        hipFuncSetAttribute((const void*)k_phase<3>, hipFuncAttributeMaxDynamicSharedMemorySize, LDS_BYTES);
        hipFuncSetAttribute((const void*)k_phase<4>, hipFuncAttributeMaxDynamicSharedMemorySize, LDS_BYTES);
        hipFuncSetAttribute((const void*)k_phase<5>, hipFuncAttributeMaxDynamicSharedMemorySize, LDS_BYTES);
        hipFuncSetAttribute((const void*)k_phase<6>, hipFuncAttributeMaxDynamicSharedMemorySize, LDS_BYTES);
        per_cu = 1;
#else
        hipFuncSetAttribute((const void*)k_mega, hipFuncAttributeMaxDynamicSharedMemorySize, LDS_BYTES);
        if (hipOccupancyMaxActiveBlocksPerMultiprocessor(&per_cu, (const void*)k_mega, 512, LDS_BYTES) != hipSuccess || per_cu < 1) {
            fprintf(stderr, "kernel_launch: occupancy query says %d blocks per CU\n", per_cu); per_cu = 1; }
        if (per_cu > 1) per_cu = 1;
#endif
        (void)hipGetLastError();
        grid = cus * per_cu;
        if (ws_size < 234 * MiB) fprintf(stderr, "kernel_launch: workspace too small (%zu)\n", ws_size);
    }
    Params p{};
    p.x_prompt = (const float*)d_in[0]; p.x_sample = (const float*)d_in[1]; p.st_pool = (const float*)d_in[2]; p.st_conv = (const float*)d_in[3]; p.st_ffn = (const float*)d_in[4];
    p.g1 = (const float*)d_in[5]; p.w_in = (const float*)d_in[6]; p.w_grp = (const float*)d_in[7]; p.pool_scale = (const float*)d_in[8]; p.conv_w = (const float*)d_in[9];
    p.w_out = (const float*)d_in[10]; p.g2 = (const float*)d_in[11]; p.w_up = (const float*)d_in[12]; p.ffn_cw = (const float*)d_in[13]; p.w_down = (const float*)d_in[14]; p.gf = (const float*)d_in[15];
    p.out = (float*)d_out; p.ws = (unsigned char*)d_ws;
#if MULTI_LAUNCH
    hipLaunchKernelGGL(k_phase<0>, dim3(grid), dim3(512), LDS_BYTES, stream, p);
    hipLaunchKernelGGL(k_phase<1>, dim3(grid), dim3(512), LDS_BYTES, stream, p);
    hipLaunchKernelGGL(k_phase<2>, dim3(grid), dim3(512), LDS_BYTES, stream, p);
    hipLaunchKernelGGL(k_phase<3>, dim3(grid), dim3(512), LDS_BYTES, stream, p);
    hipLaunchKernelGGL(k_phase<4>, dim3(grid), dim3(512), LDS_BYTES, stream, p);
    hipLaunchKernelGGL(k_phase<5>, dim3(grid), dim3(512), LDS_BYTES, stream, p);
    hipLaunchKernelGGL(k_phase<6>, dim3(grid), dim3(512), LDS_BYTES, stream, p);
#else
    (void)hipMemsetAsync((unsigned char*)d_ws + WS_BAR, 0, XCD_BAR_WORDS * 4, stream);
    void* args[] = {&p};
    hipError_t e = hipLaunchCooperativeKernel((const void*)k_mega, dim3(grid), dim3(512), args, LDS_BYTES, stream);
    if (e != hipSuccess) fprintf(stderr, "cooperative launch failed: %s (grid %d)\n", hipGetErrorString(e), grid);
#endif
}
```
